# Optimizing an MI355X kernel written in HIP

```python
import math
import jax, jax.numpy as jnp
from jax import lax
import numpy as np

D_MODEL = 1024
BATCH = 16
SEQ = 4096
DEPTH = 4

GRID_W = 64
NA_HEADS = 8
NA_HEAD_DIM = 64
NA_WIDTH = NA_HEADS * NA_HEAD_DIM
NA_WIN_R = 8
NA_WIN_C = 16
DA_HEADS = 4
DA_HEAD_DIM = 64
DA_V_DIM = 2 * DA_HEAD_DIM
DA_WIDTH = DA_HEADS * DA_V_DIM
MIX_WIDTH = NA_WIDTH + DA_WIDTH
IN_COLS = 4 * NA_WIDTH + 4 * DA_WIDTH
Q_BLOCK = 128
T5_BUCKETS = 32
T5_MAX_EXACT = 8
T5_MAX_DIST = 128
NORM_EPS = 1e-6
SUBLN_EPS = 1e-5

kernel_name = "hybrid_natten_diffattn_encoder"


def rmsnorm(x, g, eps=NORM_EPS):
    xf = x.astype(jnp.float32)
    y = xf * lax.rsqrt(jnp.mean(xf * xf, axis=-1, keepdims=True) + eps)
    return (y * g.astype(jnp.float32)).astype(x.dtype)


def t5_bucket(rel):
    n = T5_BUCKETS // 2
    ret = jnp.where(rel > 0, n, 0)
    a = jnp.abs(rel)
    small = a < T5_MAX_EXACT
    af = jnp.maximum(a, 1).astype(jnp.float32)
    large = T5_MAX_EXACT + (jnp.log(af / T5_MAX_EXACT) / math.log(T5_MAX_DIST / T5_MAX_EXACT)
                            * (n - T5_MAX_EXACT)).astype(jnp.int32)
    large = jnp.minimum(large, n - 1)
    return ret + jnp.where(small, a, large)


def neighborhood_attention(q, k, v, rpb):
    b, s, h, dh = q.shape
    rows = s // GRID_W
    wr = min(NA_WIN_R, rows)
    scale = dh ** -0.5

    def to_grid(t):
        return t.reshape(b, rows, GRID_W, h, dh).transpose(0, 3, 1, 2, 4)

    qg, kg, vg = to_grid(q), to_grid(k), to_grid(v)
    c = jnp.arange(GRID_W)
    cs = jnp.clip(c - NA_WIN_C // 2, 0, GRID_W - NA_WIN_C)
    col_idx = cs[:, None] + jnp.arange(NA_WIN_C)[None, :]
    col_bias_idx = col_idx - c[:, None] + (NA_WIN_C - 1)

    def row_step(r):
        rs = jnp.clip(r - wr // 2, 0, rows - wr)
        qr = lax.dynamic_index_in_dim(qg, r, axis=2, keepdims=False)
        kr = lax.dynamic_slice_in_dim(kg, rs, wr, axis=2)[:, :, :, col_idx]
        vr = lax.dynamic_slice_in_dim(vg, rs, wr, axis=2)[:, :, :, col_idx]
        row_bias_idx = rs + jnp.arange(wr) - r + (NA_WIN_R - 1)
        bias = rpb[:, row_bias_idx][:, :, col_bias_idx]
        bias = bias.transpose(0, 2, 1, 3).astype(jnp.float32)
        logits = jnp.einsum('bhcd,bhicjd->bhcij', qr, kr).astype(jnp.float32) * scale + bias[None]
        p = jax.nn.softmax(logits.reshape(b, h, GRID_W, wr * NA_WIN_C), axis=-1)
        p = p.reshape(b, h, GRID_W, wr, NA_WIN_C).astype(vr.dtype)
        return jnp.einsum('bhcij,bhicjd->bhcd', p, vr)

    out = lax.map(row_step, jnp.arange(rows))
    return out.transpose(1, 0, 3, 2, 4).reshape(b, s, h * dh)


def diff_attention(q, k, v, t5_table, lam, lam_init, subln_g):
    b, s, h, _, dh = q.shape
    nb = s // Q_BLOCK
    scale = dh ** -0.5
    qb = q.reshape(b, nb, Q_BLOCK, h, 2, dh).transpose(1, 0, 2, 3, 4, 5)
    kpos = jnp.arange(s)

    def block_step(args):
        qblk, i = args
        qpos = i * Q_BLOCK + jnp.arange(Q_BLOCK)
        bias = t5_table[t5_bucket(kpos[None, :] - qpos[:, None])]
        bias = bias.transpose(2, 0, 1).astype(jnp.float32)
        logits = jnp.einsum('bqhtd,bkhtd->bhtqk', qblk, k).astype(jnp.float32) * scale
        p = jax.nn.softmax(logits + bias[None, :, None], axis=-1)
        attn = (p[:, :, 0] - lam * p[:, :, 1]).astype(v.dtype)
        return jnp.einsum('bhqk,bkhe->bqhe', attn, v)

    out = lax.map(block_step, (qb, jnp.arange(nb)))
    out = out.transpose(1, 0, 2, 3, 4).reshape(b, s, h, DA_V_DIM)
    out = rmsnorm(out, subln_g, eps=SUBLN_EPS) * (1.0 - lam_init)
    return out.reshape(b, s, h * DA_V_DIM)


def setup_inputs(seed: int = 0) -> dict:
    key = jax.random.key(seed)
    ks = jax.random.split(key, 12)
    f32 = jnp.float32
    x = jax.random.normal(ks[0], (BATCH, SEQ, D_MODEL), f32)
    norm_g = 1.0 + 0.01 * jax.random.normal(ks[1], (DEPTH, D_MODEL), f32)
    w_in = jax.random.normal(ks[2], (DEPTH, D_MODEL, IN_COLS), f32) * D_MODEL ** -0.5
    na_rpb = 0.1 * jax.random.normal(ks[3], (DEPTH, NA_HEADS, 2 * NA_WIN_R - 1, 2 * NA_WIN_C - 1), f32)
    lambda_q1 = 0.1 * jax.random.normal(ks[4], (DEPTH, DA_HEAD_DIM), f32)
    lambda_k1 = 0.1 * jax.random.normal(ks[5], (DEPTH, DA_HEAD_DIM), f32)
    lambda_q2 = 0.1 * jax.random.normal(ks[6], (DEPTH, DA_HEAD_DIM), f32)
    lambda_k2 = 0.1 * jax.random.normal(ks[7], (DEPTH, DA_HEAD_DIM), f32)
    subln_g = 1.0 + 0.01 * jax.random.normal(ks[8], (DEPTH, DA_V_DIM), f32)
    t5_table = 0.1 * jax.random.normal(ks[9], (T5_BUCKETS, DA_HEADS), f32)
    w_out = jax.random.normal(ks[10], (DEPTH, MIX_WIDTH, D_MODEL), f32) * MIX_WIDTH ** -0.5
    final_g = 1.0 + 0.01 * jax.random.normal(ks[11], (D_MODEL,), f32)
    return {"x": x, "norm_g": norm_g, "w_in": w_in, "na_rpb": na_rpb,
            "lambda_q1": lambda_q1, "lambda_k1": lambda_k1,
            "lambda_q2": lambda_q2, "lambda_k2": lambda_k2,
            "subln_g": subln_g, "t5_table": t5_table,
            "w_out": w_out, "final_g": final_g}


def reference(x, norm_g, w_in, na_rpb, lambda_q1, lambda_k1, lambda_q2, lambda_k2,
              subln_g, t5_table, w_out, final_g):
    b, s, _ = x.shape
    A = NA_WIDTH
    o_b = 4 * NA_WIDTH
    Bw = DA_WIDTH
    for l in range(DEPTH):
        h = rmsnorm(x, norm_g[l])
        proj = h @ w_in[l]
        q_a = proj[..., 0:A].reshape(b, s, NA_HEADS, NA_HEAD_DIM)
        k_a = proj[..., A:2 * A].reshape(b, s, NA_HEADS, NA_HEAD_DIM)
        v_a = proj[..., 2 * A:3 * A].reshape(b, s, NA_HEADS, NA_HEAD_DIM)
        g_a = proj[..., 3 * A:4 * A]
        out_a = neighborhood_attention(q_a, k_a, v_a, na_rpb[l])
        q_b = proj[..., o_b:o_b + Bw].reshape(b, s, DA_HEADS, 2, DA_HEAD_DIM)
        k_b = proj[..., o_b + Bw:o_b + 2 * Bw].reshape(b, s, DA_HEADS, 2, DA_HEAD_DIM)
        v_b = proj[..., o_b + 2 * Bw:o_b + 3 * Bw].reshape(b, s, DA_HEADS, DA_V_DIM)
        g_b = proj[..., o_b + 3 * Bw:o_b + 4 * Bw]
        lam_init = 0.8 - 0.6 * math.exp(-0.3 * l)
        lam = (jnp.exp(jnp.sum(lambda_q1[l].astype(jnp.float32) * lambda_k1[l].astype(jnp.float32)))
               - jnp.exp(jnp.sum(lambda_q2[l].astype(jnp.float32) * lambda_k2[l].astype(jnp.float32)))
               + lam_init)
        out_b = diff_attention(q_b, k_b, v_b, t5_table, lam, lam_init, subln_g[l])
        y = jnp.concatenate([out_a * jax.nn.silu(g_a), out_b * jax.nn.silu(g_b)], axis=-1)
        x = x + y @ w_out[l]
    return rmsnorm(x, final_g)
```

```cpp
#include <hip/hip_runtime.h>
#include <hip/hip_cooperative_groups.h>
#include <cstdio>
#include <cstdint>
namespace cg = cooperative_groups;
namespace pg8 {
#define PG8_LAS __attribute__((address_space(3)))
typedef unsigned short bf16_t;
typedef short bf16x8 __attribute__((ext_vector_type(8)));
typedef float f32x4 __attribute__((ext_vector_type(4)));
typedef unsigned u32x4 __attribute__((ext_vector_type(4)));
constexpr int BM = 256, BK = 64, HALF = 128, HTB = HALF * BK * 2  , STAGE_BYTES = 8 * HTB, NXCD = 8, WGM = 8;

__host__ __device__ __forceinline__ int lds_byte(int r, int c) { const int st = (r >> 4) * 2 + (c >> 5), rr = r & 15, cc = c & 31, ob = rr * 64 + cc * 2; return st * 1024 + (ob ^ (((ob >> 9) & 1) << 5)); }
__host__ __device__ __forceinline__ void stage_rc(int b, int& R, int& C) { const int st = b / 1024, sb = b % 1024, swz = sb ^ (((sb >> 9) & 1) << 5); R = (st >> 1) * 16 + swz / 64; C = (st & 1) * 32 + (swz % 64) / 2; }
__host__ __device__ __forceinline__ int perm32(int rho) { const int n = rho >> 4, i = rho & 15; return 8 * (i >> 2) + 4 * n + (i & 3); }

struct Unit { int pm, pn; };
struct Gemm { const bf16_t* A; const bf16_t* Bt; int M, N, K; };

struct StaticOrder {
    int nM, nN, nwg, G, c;
    __host__ __device__ void init(int M, int N, int G_, int c_) { nM = M / BM; nN = N / BM; nwg = nM * nN; G = G_; c = c_; }
    __host__ __device__ bool next(int i, Unit& u) const {
        const long L = (long)i * G + c; if (L >= nwg) return false;
        int wgid = (int)L; { const int q = nwg / NXCD, r = nwg % NXCD, xcd = wgid % NXCD, off = wgid / NXCD; wgid = (xcd < r ? xcd * (q + 1) : r * (q + 1) + (xcd - r) * q) + off; }
        const int nig = WGM * nN, gid = wgid / nig, fm = gid * WGM, gsz = (nM - fm) < WGM ? (nM - fm) : WGM;
        u.pm = fm + ((wgid % nig) % gsz); u.pn = (wgid % nig) / gsz; return true;
    }
    __device__ __forceinline__ void a_ready(const Unit&) const {}
    __device__ __forceinline__ void done(const Unit&) const {}
};

typedef float f32x2_t __attribute__((ext_vector_type(2))); typedef __bf16 bf16x2_t __attribute__((ext_vector_type(2)));
__device__ __forceinline__ unsigned cvtpk(float lo, float hi) { f32x2_t v = {lo, hi}; bf16x2_t b = __builtin_convertvector(v, bf16x2_t); return __builtin_bit_cast(unsigned, b); }
typedef unsigned u32x2 __attribute__((ext_vector_type(2)));
__device__ __forceinline__ float sum_rows4(float v) {
    auto a = __builtin_amdgcn_permlane16_swap(__float_as_uint(v), __float_as_uint(v), false, false); const float s = __uint_as_float(a[0]) + __uint_as_float(a[1]);
    auto b = __builtin_amdgcn_permlane32_swap(__float_as_uint(s), __float_as_uint(s), false, false); return __uint_as_float(b[0]) + __uint_as_float(b[1]);
}

struct EpiProj {
    static constexpr bool PERM = true, AFTER_DRAIN = false;
    bf16_t* O; const float* ssq; int ldc;
    __device__ __forceinline__ void operator()(const f32x4 (&acc)[2][2][4][2], const Unit& u, int wr, int wc, int fr, int fq) const {
        const int row0 = u.pm * BM + wr * 64 + fr; const int col0 = u.pn * BM + wc * 32 + 8 * fq;
#pragma unroll
        for (int ai = 0; ai < 2; ++ai)
#pragma unroll
            for (int m = 0; m < 4; ++m) {
                const int row = row0 + ai * HALF + m * 16;
                const f32x4 a = *((const f32x4*)(ssq + (size_t)row * 16) + fq);
                float tot = (a[0] + a[1]) + (a[2] + a[3]);
                tot = sum_rows4(tot);
                const float rs = __builtin_amdgcn_rsqf(tot * (1.0f / 1024.0f) + 1e-6f);
                bf16_t* rowp = O + (size_t)row * ldc + col0;
#pragma unroll
                for (int bj = 0; bj < 2; ++bj) { const f32x4 v0 = acc[ai][bj][m][0] * rs, v1 = acc[ai][bj][m][1] * rs;
                    u32x4 w; w.x = cvtpk(v0[0], v0[1]); w.y = cvtpk(v0[2], v0[3]); w.z = cvtpk(v1[0], v1[1]); w.w = cvtpk(v1[2], v1[3]);
                    *(u32x4*)(rowp + bj * HALF) = w; }
                asm volatile("" ::: "memory"); }
    }
};
struct EpiOut {
    static constexpr bool PERM = true, AFTER_DRAIN = false;
    bf16_t* xb; float* ssq;
    __device__ __forceinline__ void operator()(const f32x4 (&acc)[2][2][4][2], const Unit& u, int wr, int wc, int fr, int fq) const {
        const int col0 = u.pn * BM + wc * 32 + 8 * fq;
#pragma unroll
        for (int ai = 0; ai < 2; ++ai)
#pragma unroll
            for (int m = 0; m < 4; ++m) {
                const int row = u.pm * BM + ai * HALF + wr * 64 + m * 16 + fr; const size_t off = (size_t)row * 1024 + col0;
                float q = 0.f;
#pragma unroll
                for (int bj = 0; bj < 2; ++bj) { u32x4* p = (u32x4*)(xb + off + bj * HALF); const u32x4 b = *p;
                    f32x4 o0, o1; o0[0] = __uint_as_float(b.x << 16); o0[1] = __uint_as_float(b.x & 0xffff0000u); o0[2] = __uint_as_float(b.y << 16); o0[3] = __uint_as_float(b.y & 0xffff0000u);
                    o1[0] = __uint_as_float(b.z << 16); o1[1] = __uint_as_float(b.z & 0xffff0000u); o1[2] = __uint_as_float(b.w << 16); o1[3] = __uint_as_float(b.w & 0xffff0000u);
                    o0 = o0 + acc[ai][bj][m][0]; o1 = o1 + acc[ai][bj][m][1];
                    q += ((o0[0] * o0[0] + o0[1] * o0[1]) + (o0[2] * o0[2] + o0[3] * o0[3])) + ((o1[0] * o1[0] + o1[1] * o1[1]) + (o1[2] * o1[2] + o1[3] * o1[3]));
                    u32x4 w; w.x = cvtpk(o0[0], o0[1]); w.y = cvtpk(o0[2], o0[3]); w.z = cvtpk(o1[0], o1[1]); w.w = cvtpk(o1[2], o1[3]); *p = w; }
                q = sum_rows4(q);
                if (fq == 0) ssq[(size_t)row * 16 + u.pn * 4 + wc] = q;
                asm volatile("" ::: "memory");
            }
    }
};
template <class Epi, class Sched, bool ALIGN_EPI = false, bool SP2 = false>
__device__ __forceinline__ void gemm_phase(PG8_LAS unsigned char* lds, const Gemm g, const Sched& S, const Epi& E) {
    int tid = threadIdx.x; asm volatile("" : "+v"(tid));
    const int wid = __builtin_amdgcn_readfirstlane(tid >> 6), lane = tid & 63, wr = wid >> 2, wc = wid & 3, fr = lane & 15, fq = lane >> 4;
    const int K = g.K, nt = K / BK;
    unsigned voffA[2], voffB[2];
#pragma unroll
    for (int i = 0; i < 2; ++i) { int R, C; stage_rc(tid * 16 + i * 8192, R, C); const int Rb = Epi::PERM ? ((R & ~31) + perm32(R & 31)) : R;
        voffA[i] = (unsigned)(R * K + C) * 2u; voffB[i] = (unsigned)(Rb * K + C) * 2u; }
    const size_t kstep = (size_t)(BK * 2);
    const size_t hstep = (size_t)HALF * K * 2;
    const size_t tstep = 2 * hstep;
    const unsigned ldsw = (unsigned)wid * 1024u;
    const int aoff = lds_byte(wr * 64 + fr, fq * 8), boff = lds_byte(wc * 32 + fr, fq * 8);
#define PG8_SA(b, h) (((b) * 2 + (h)) * HTB)
#define PG8_SB(b, h) ((4 + (b) * 2 + (h)) * HTB)
#define PG8_STAGE(bufoff, gbase, voff) do { _Pragma("unroll") for (int _i = 0; _i < 2; ++_i) \
        __builtin_amdgcn_global_load_lds((const unsigned*)((const char*)(gbase) + (voff)[_i]), (PG8_LAS unsigned*)(lds + (bufoff) + ldsw + _i * 8192), 16, 0, 0); } while (0)
#define PG8_LDA(dst, b, h) do { _Pragma("unroll") for (int m = 0; m < 4; ++m) _Pragma("unroll") for (int k = 0; k < 2; ++k) dst[m][k] = *(const PG8_LAS bf16x8*)(lds + PG8_SA(b, h) + aoff + m * 2048 + k * 1024); } while (0)
#define PG8_LDB(dst, b, h) do { _Pragma("unroll") for (int n = 0; n < 2; ++n) _Pragma("unroll") for (int k = 0; k < 2; ++k) dst[n][k] = *(const PG8_LAS bf16x8*)(lds + PG8_SB(b, h) + boff + n * 2048 + k * 1024); } while (0)
#define PG8_MMA(ai, bj, At, Bt) do { __builtin_amdgcn_s_setprio(1); _Pragma("unroll") for (int m = 0; m < 4; ++m) _Pragma("unroll") for (int n = 0; n < 2; ++n) _Pragma("unroll") for (int k = 0; k < 2; ++k) \
        acc[ai][bj][m][n] = __builtin_amdgcn_mfma_f32_16x16x32_bf16(Bt[n][k], At[m][k], acc[ai][bj][m][n], 0, 0, 0); __builtin_amdgcn_s_setprio(0); } while (0)
#define PG8_WAIT_V(n) asm volatile("s_waitcnt vmcnt(" #n ")" ::: "memory")
#define PG8_WAIT_L(n) asm volatile("s_waitcnt lgkmcnt(" #n ")" ::: "memory")
#define PG8_BAR __builtin_amdgcn_s_barrier()
#define PG8_SCHED __builtin_amdgcn_sched_barrier(0)
    Unit cur, nxt; int ui = 0;
    if (!S.next(0, cur)) return;
    f32x4 acc[2][2][4][2];
#pragma unroll
    for (int a = 0; a < 2; ++a)
#pragma unroll
        for (int b = 0; b < 2; ++b)
#pragma unroll
            for (int m = 0; m < 4; ++m)
#pragma unroll
                for (int n = 0; n < 2; ++n) acc[a][b][m][n] = (f32x4){0.f, 0.f, 0.f, 0.f};
    bf16x8 At[4][2], B0[2][2], B1[2][2];
    const char* cA = (const char*)g.A + (size_t)cur.pm * tstep; const char* cB = (const char*)g.Bt + (size_t)cur.pn * tstep;
    S.a_ready(cur);
    if constexpr (SP2) {
        PG8_STAGE(PG8_SB(0, 0), cB, voffB); PG8_STAGE(PG8_SB(0, 1), cB + hstep, voffB); PG8_STAGE(PG8_SA(0, 0), cA, voffA); PG8_STAGE(PG8_SA(0, 1), cA + hstep, voffA);
        if (wr == 1) PG8_BAR;
        PG8_WAIT_V(2); PG8_BAR;
        PG8_STAGE(PG8_SB(1, 0), cB + kstep, voffB); PG8_STAGE(PG8_SA(1, 0), cA + kstep, voffA); PG8_STAGE(PG8_SB(1, 1), cB + hstep + kstep, voffB);
        PG8_WAIT_V(6); PG8_BAR;
    } else {
        PG8_STAGE(PG8_SB(0, 0), cB, voffB); PG8_STAGE(PG8_SA(0, 0), cA, voffA); PG8_STAGE(PG8_SB(0, 1), cB + hstep, voffB); PG8_STAGE(PG8_SA(0, 1), cA + hstep, voffA);
        if (wr == 1) PG8_BAR;
        PG8_WAIT_V(4); PG8_BAR;
        PG8_STAGE(PG8_SB(1, 0), cB + kstep, voffB); PG8_STAGE(PG8_SA(1, 0), cA + kstep, voffA); PG8_STAGE(PG8_SB(1, 1), cB + hstep + kstep, voffB);
        PG8_WAIT_V(6); PG8_BAR;
    }
    for (;;) {
        const bool has_next = S.next(ui + 1, nxt);
        const char* nA = has_next ? (const char*)g.A + (size_t)nxt.pm * tstep : cA; const char* nB = has_next ? (const char*)g.Bt + (size_t)nxt.pn * tstep : cB;
        for (int t = 0; t < nt; t += 2) {
            const bool last = (t == nt - 2);
            const char* a1 = cA + (size_t)(t + 1) * kstep;
            const char* a2 = last ? nA : cA + (size_t)(t + 2) * kstep; const char* b2 = last ? nB : cB + (size_t)(t + 2) * kstep;
            const char* a3 = a2 + kstep; const char* b3 = b2 + kstep;
            if (last && has_next) S.a_ready(nxt);
            if constexpr (SP2) {
            PG8_LDB(B0, 0, 0); PG8_LDB(B1, 0, 1); PG8_SCHED; PG8_LDA(At, 0, 0); PG8_STAGE(PG8_SA(1, 1), a1 + hstep, voffA);
            PG8_WAIT_V(8); PG8_WAIT_L(0); PG8_BAR; PG8_MMA(0, 0, At, B0); PG8_MMA(0, 1, At, B1); PG8_BAR; PG8_SCHED;
            PG8_LDA(At, 0, 1); PG8_STAGE(PG8_SB(0, 0), b2, voffB); PG8_STAGE(PG8_SB(0, 1), b2 + hstep, voffB); PG8_STAGE(PG8_SA(0, 0), a2, voffA);
            PG8_WAIT_V(8); PG8_WAIT_L(0); PG8_BAR; PG8_MMA(1, 0, At, B0); PG8_MMA(1, 1, At, B1); PG8_BAR; PG8_SCHED;
            PG8_LDB(B0, 1, 0); PG8_LDB(B1, 1, 1); PG8_SCHED; PG8_LDA(At, 1, 0); PG8_STAGE(PG8_SA(0, 1), a2 + hstep, voffA);
            PG8_WAIT_V(8); PG8_WAIT_L(0); PG8_BAR; PG8_MMA(0, 0, At, B0); PG8_MMA(0, 1, At, B1); PG8_BAR; PG8_SCHED;
            PG8_LDA(At, 1, 1); PG8_STAGE(PG8_SB(1, 0), b3, voffB); PG8_STAGE(PG8_SB(1, 1), b3 + hstep, voffB); PG8_STAGE(PG8_SA(1, 0), a3, voffA);
            PG8_WAIT_V(8); PG8_WAIT_L(0); PG8_BAR; PG8_MMA(1, 0, At, B0); PG8_MMA(1, 1, At, B1); PG8_BAR; PG8_SCHED;
            } else {
            PG8_LDB(B0, 0, 0); PG8_SCHED; PG8_LDA(At, 0, 0); PG8_STAGE(PG8_SA(1, 1), a1 + hstep, voffA);
            PG8_WAIT_L(8); PG8_BAR; PG8_WAIT_L(0); PG8_MMA(0, 0, At, B0); PG8_BAR; PG8_SCHED;
            PG8_LDB(B1, 0, 1); PG8_STAGE(PG8_SB(0, 0), b2, voffB);
            PG8_BAR; PG8_WAIT_L(0); PG8_MMA(0, 1, At, B1); PG8_BAR;
            PG8_LDA(At, 0, 1); PG8_STAGE(PG8_SA(0, 0), a2, voffA);
            PG8_BAR; PG8_WAIT_L(0); PG8_MMA(1, 0, At, B0); PG8_BAR; PG8_SCHED;
            PG8_STAGE(PG8_SB(0, 1), b2 + hstep, voffB);
            PG8_WAIT_V(6); PG8_BAR; PG8_MMA(1, 1, At, B1); PG8_BAR;
            PG8_LDB(B0, 1, 0); PG8_SCHED; PG8_LDA(At, 1, 0); PG8_STAGE(PG8_SA(0, 1), a2 + hstep, voffA);
            PG8_WAIT_L(8); PG8_BAR; PG8_WAIT_L(0); PG8_MMA(0, 0, At, B0); PG8_BAR; PG8_SCHED;
            PG8_LDB(B1, 1, 1); PG8_STAGE(PG8_SB(1, 0), b3, voffB);
            PG8_BAR; PG8_WAIT_L(0); PG8_MMA(0, 1, At, B1); PG8_BAR;
            PG8_LDA(At, 1, 1); PG8_STAGE(PG8_SA(1, 0), a3, voffA);
            PG8_BAR; PG8_WAIT_L(0); PG8_MMA(1, 0, At, B0); PG8_BAR; PG8_SCHED;
            PG8_STAGE(PG8_SB(1, 1), b3 + hstep, voffB);
            PG8_WAIT_V(6); PG8_BAR; PG8_MMA(1, 1, At, B1); PG8_BAR;
            }
        }
        if constexpr (ALIGN_EPI) { if (wr == 0) PG8_BAR; }
        if constexpr (!Epi::AFTER_DRAIN) { E(acc, cur, wr, wc, fr, fq); S.done(cur); }
        if (!has_next) break;
#pragma unroll
        for (int a = 0; a < 2; ++a)
#pragma unroll
            for (int b = 0; b < 2; ++b)
#pragma unroll
                for (int m = 0; m < 4; ++m)
#pragma unroll
                    for (int n = 0; n < 2; ++n) acc[a][b][m][n] = (f32x4){0.f, 0.f, 0.f, 0.f};
        cur = nxt; cA = nA; cB = nB; ++ui;
        if constexpr (ALIGN_EPI) { if (wr == 1) PG8_BAR; }
    }
    PG8_WAIT_V(0);
    if constexpr (!ALIGN_EPI) { if (wr == 0) PG8_BAR; }
    PG8_BAR;
    if constexpr (Epi::AFTER_DRAIN) { E.fused(acc, cur, wr, wc, fr, fq, lds, wid, lane); S.done(cur); }
#undef PG8_SA
#undef PG8_SB
#undef PG8_STAGE
#undef PG8_LDA
#undef PG8_LDB
#undef PG8_MMA
#undef PG8_WAIT_V
#undef PG8_WAIT_L
#undef PG8_BAR
#undef PG8_SCHED
}
}
namespace att {
#define LAS __attribute__((address_space(3)))
typedef unsigned short bf16_t;
typedef short bf16x8 __attribute__((ext_vector_type(8)));
typedef float f32x4 __attribute__((ext_vector_type(4)));
typedef float f32x16 __attribute__((ext_vector_type(16)));
typedef unsigned u32x4 __attribute__((ext_vector_type(4)));
typedef unsigned u32x2 __attribute__((ext_vector_type(2)));
typedef float f32x2 __attribute__((ext_vector_type(2)));
using pg8::cvtpk;
constexpr float LOG2E = 1.4426950408889634f;
constexpr float QK_C = 0.125f * LOG2E;
constexpr float MASKED = -3.0e38f, M_INIT = -1.0e30f;
constexpr int DA_KROW = 272, DA_VROW = 128, DA_V_OFF = 64 * DA_KROW, DA_BUF = DA_V_OFF + 128 * DA_VROW, DA_TBL_OFF = 3 * DA_BUF;
constexpr int DA_DL_OFF = DA_TBL_OFF + 3072, DA_DR_OFF = DA_DL_OFF + 2816;
constexpr int NA_SLOT = 64 * 128, NA_TBL_OFF = 11 * NA_SLOT;
static_assert(DA_DR_OFF + 641 * 4 <= 131072 && DA_V_OFF % 128 == 0 && DA_BUF % 128 == 0 && DA_TBL_OFF + 257 * 4 <= 131072 && NA_TBL_OFF + 512 * 4 <= 131072, "attention LDS");

__device__ __forceinline__ int crow(int r, int hi) { return (r & 3) + 8 * (r >> 2) + 4 * hi; }
__device__ __forceinline__ float ex2(float x) { return __builtin_amdgcn_exp2f(x); }
__device__ __forceinline__ float silu(float g) { return g * __builtin_amdgcn_rcpf(1.0f + __builtin_amdgcn_exp2f(g * -1.4426950408889634f)); }
__device__ __forceinline__ f32x16 mfma32(bf16x8 a, bf16x8 b, f32x16 c) { return __builtin_amdgcn_mfma_f32_32x32x16_bf16(a, b, c, 0, 0, 0); }
__device__ __forceinline__ int clampi(int v, int lo, int hi) { return v < lo ? lo : (v > hi ? hi : v); }

__device__ __forceinline__ float xh_max(float v) { auto rr = __builtin_amdgcn_permlane32_swap(__float_as_uint(v), __float_as_uint(v), false, false); return fmaxf(__uint_as_float(rr[0]), __uint_as_float(rr[1])); }
__device__ __forceinline__ float xh_sum(float v) { auto rr = __builtin_amdgcn_permlane32_swap(__float_as_uint(v), __float_as_uint(v), false, false); return __uint_as_float(rr[0]) + __uint_as_float(rr[1]); }
__device__ __forceinline__ float rowmax16(const f32x16& z) {
    float a = fmaxf(fmaxf(z[0], z[1]), z[2]), b = fmaxf(fmaxf(z[3], z[4]), z[5]);
    a = fmaxf(fmaxf(a, z[6]), z[7]); b = fmaxf(fmaxf(b, z[8]), z[9]); a = fmaxf(fmaxf(a, z[10]), z[11]); b = fmaxf(fmaxf(b, z[12]), z[13]); a = fmaxf(fmaxf(a, z[14]), z[15]);
    return fmaxf(a, b);
}
template <int NT> __device__ __forceinline__ void softmax_step(f32x16& z, float& m, float& l, f32x16 (&o)[NT], u32x4& p0, u32x4& p1) {
    float e[16], su = 0.f;
#pragma unroll
    for (int r = 0; r < 16; ++r) { e[r] = ex2(z[r] - m); su += e[r]; }
    if (__builtin_amdgcn_ballot_w64(!(su < 1048576.0f)) != 0ull) {
        float zm = fmaxf(fmaxf(z[0], z[1]), fmaxf(z[2], z[3]));
#pragma unroll
        for (int r = 4; r < 16; r += 4) zm = fmaxf(zm, fmaxf(fmaxf(z[r], z[r + 1]), fmaxf(z[r + 2], z[r + 3])));
        zm = xh_max(zm);
        const bool need = zm > m + 8.0f;
        const float mn = need ? zm : m;
        const float f = ex2(m - mn);
        l *= f;
#pragma unroll
        for (int t = 0; t < NT; ++t)
#pragma unroll
            for (int r = 0; r < 16; ++r) o[t][r] *= f;
        m = mn;
        su = 0.f;
#pragma unroll
        for (int r = 0; r < 16; ++r) { e[r] = ex2(z[r] - m); su += e[r]; }
    }
    l += su;
    p0.x = cvtpk(e[0], e[1]); p0.y = cvtpk(e[2], e[3]); p0.z = cvtpk(e[4], e[5]); p0.w = cvtpk(e[6], e[7]);
    p1.x = cvtpk(e[8], e[9]); p1.y = cvtpk(e[10], e[11]); p1.z = cvtpk(e[12], e[13]); p1.w = cvtpk(e[14], e[15]);
}
__device__ __forceinline__ void tr_store(LAS unsigned char* p, const u32x4 a, const u32x4 b) {
#pragma unroll
    for (int i = 0; i < 4; ++i) {
        *(LAS unsigned*)(p + (2 * i) * 144) = (a[i] & 0xffffu) | (b[i] << 16);
        *(LAS unsigned*)(p + (2 * i + 1) * 144) = (a[i] >> 16) | (b[i] & 0xffff0000u);
    }
}
__device__ __forceinline__ int vpos_of(int c) { const int c16 = c & 15; return (c & ~15) + 8 * ((c16 >> 2) & 1) + (c16 & 3) + 4 * (c16 >> 3); }

__device__ __forceinline__ void store_pair16(bf16_t* p, int hh, u32x2 a, u32x2 b) {
    auto r0 = __builtin_amdgcn_permlane32_swap(a.x, b.x, false, false); auto r1 = __builtin_amdgcn_permlane32_swap(a.y, b.y, false, false);
    const u32x4 st = {r0[0], r1[0], r0[1], r1[1]};
    *(u32x4*)(p + 8 * hh) = st;
}
__device__ __forceinline__ int vsw(int d) { return ((d >> 3) & 1) | (((d >> 4) & 1) << 1) | ((((d >> 1) ^ (d >> 5)) & 1) << 2); }
__device__ __forceinline__ void da_unit(LAS unsigned char* lds, const bf16_t* __restrict__ proj, bf16_t* __restrict__ y, int unit,
                                        const float* __restrict__ t5, float lam, float one_m_li, const float* __restrict__ subg) {
    int tid = threadIdx.x; asm volatile("" : "+v"(tid));
    const int lane = tid & 63, wid = __builtin_amdgcn_readfirstlane(tid >> 6), l31 = lane & 31, hh = lane >> 5;
    const int qg = wid >> 1, mp = wid & 1;
    const int bh = unit >> 5, qb = unit & 31, b = bh >> 2, h = bh & 3;
    const size_t rowbase = (size_t)b * 4096;
    const int qblk = qb * 128, q0 = qblk + qg * 32, q = q0 + l31;
    LAS float* tbl = (LAS float*)(lds + DA_TBL_OFF);
    __syncthreads();
    if (tid < 257) { const int rel = tid - 128, a = rel < 0 ? -rel : rel; int large = 8 + (31 - __builtin_clz((unsigned)(a * a) | 1u)) - 6; large = large > 15 ? 15 : large;
        const int bucket = (rel > 0 ? 16 : 0) + (a < 8 ? a : large); tbl[tid] = t5[bucket * 4 + h] * LOG2E; }
    LAS float* sgt = (LAS float*)(lds + DA_TBL_OFF + 2048);
    if (tid >= 384) sgt[tid - 384] = subg[tid - 384];
    { const float bl_ = t5[15 * 4 + h], br_ = t5[31 * 4 + h];
#pragma unroll
      for (int k_ = 0; k_ < 3; ++k_) { const int e_ = tid + 512 * k_;
          if (e_ < 2 * 641) { const int side = e_ >= 641 ? 1 : 0, rel0 = e_ - 641 * side - 320, rel = clampi(rel0, -128, 128), a = rel < 0 ? -rel : rel;
              int large = 8 + (31 - __builtin_clz((unsigned)(a * a) | 1u)) - 6; large = large > 15 ? 15 : large;
              const int bucket = (rel > 0 ? 16 : 0) + (a < 8 ? a : large);
              ((LAS float*)(lds + DA_DL_OFF))[e_ + (side ? (DA_DR_OFF - DA_DL_OFF) / 4 - 641 : 0)] = (t5[bucket * 4 + h] - (side ? br_ : bl_)) * (LOG2E / QK_C); } } }
    float tbmax = t5[l31 * 4 + h] * LOG2E;
#pragma unroll
    for (int o_ = 1; o_ < 32; o_ <<= 1) tbmax = fmaxf(tbmax, __shfl_xor(tbmax, o_));
    const bf16_t* qp = proj + (rowbase + q) * 4096 + 2048 + h * 128 + mp * 64 + hh * 8;
    bf16x8 qf[4];
#pragma unroll
    for (int ks = 0; ks < 4; ++ks) qf[ks] = *(const bf16x8*)(qp + ks * 16);
    const int kc = tid & 15, kr = tid >> 4;
    const bf16_t* kvbase = proj + rowbase * 4096 + 2560 + h * 128;
    const unsigned kgo = (unsigned)(kr * 4096 + kc * 8), vgo = (unsigned)(2 * kr * 4096 + 512 + kc * 8);
    const int vps = vpos_of(2 * kr), vch = vps >> 3, vswc = vsw(8 * kc);
    const unsigned kw = kr * DA_KROW + kc * 16, vwb = DA_V_OFF + (8 * kc) * DA_VROW + ((vps & 7) >> 1) * 4;
    const unsigned vwA = vwb + ((vch ^ vswc) << 4), vwB = vwb + ((vch ^ vswc ^ 4) << 4);
    const unsigned vrd = (unsigned)(DA_V_OFF + l31 * DA_VROW) ^ (unsigned)((hh ^ vsw(l31)) << 4);
    u32x4 kreg0, kreg1, vreg0, vreg1;
#define DA_LOAD(j) do { const bf16_t* t_ = kvbase + (size_t)(j) * 64 * 4096; kreg0 = *(const u32x4*)(t_ + kgo); kreg1 = *(const u32x4*)(t_ + (kgo + 32u * 4096u)); vreg0 = *(const u32x4*)(t_ + vgo); vreg1 = *(const u32x4*)(t_ + (vgo + 4096u)); } while (0)
#define DA_STORE(B_) do { *(LAS u32x4*)((B_) + kw) = kreg0; *(LAS u32x4*)((B_) + kw + 32 * DA_KROW) = kreg1; \
        _Pragma("unroll") for (int i_ = 0; i_ < 4; ++i_) { LAS unsigned char* p_ = (B_) + ((i_ & 1) ? vwB : vwA) + (2 * i_) * DA_VROW; \
            *(LAS unsigned*)(p_) = __builtin_amdgcn_perm(vreg1[i_], vreg0[i_], 0x05040100u); *(LAS unsigned*)(p_ + DA_VROW) = __builtin_amdgcn_perm(vreg1[i_], vreg0[i_], 0x07060302u); } } while (0)
#define DA_KLD(KF_, Bk, sub) do { const LAS unsigned char* kp_ = (Bk) + (32 * (sub) + l31) * DA_KROW + mp * 128 + hh * 16; \
        _Pragma("unroll") for (int ks = 0; ks < 4; ++ks) KF_[ks] = *(const LAS bf16x8*)(kp_ + ks * 32); } while (0)
#define DA_VLD(VF_, Bv, sub, s2_) do { const unsigned r_ = (unsigned)(uintptr_t)(Bv) + vrd; \
        _Pragma("unroll") for (int dt = 0; dt < 4; ++dt) VF_[dt] = *(const LAS bf16x8*)(uintptr_t)((r_ ^ (unsigned)((4 * (sub) + 2 * (s2_)) ^ ((dt & 1) << 2)) << 4) + dt * 32 * DA_VROW); } while (0)
#define DA_QKM(S_, KF_) do { { f32x16 z_; _Pragma("unroll") for (int r_ = 0; r_ < 16; ++r_) z_[r_] = 0.f; S_ = mfma32(KF_[0], qf[0], z_); } _Pragma("unroll") for (int ks = 1; ks < 4; ++ks) S_ = mfma32(KF_[ks], qf[ks], S_); } while (0)
#define DA_PVM(VF_, P_) do { _Pragma("unroll") for (int dt = 0; dt < 4; ++dt) o[dt] = mfma32(VF_[dt], __builtin_bit_cast(bf16x8, P_), o[dt]); } while (0)
#define SB0() __builtin_amdgcn_sched_barrier(0)
#define DA_RESC(sm_, bc_) do { const float zm_ = (sm_) * QK_C + (bc_); const bool need_ = zm_ > m + 8.0f; \
        if (__builtin_amdgcn_ballot_w64(need_) != 0ull) { const float mn_ = need_ ? zm_ : m; const float f_ = ex2(m - mn_); l *= f_; \
            _Pragma("unroll") for (int t_ = 0; t_ < 4; ++t_) _Pragma("unroll") for (int r_ = 0; r_ < 16; ++r_) o[t_][r_] *= f_; \
            m = mn_; } } while (0)
#define DA_EXPO(S_, bc_, P0_, P1_, su_) do { const float c_ = (bc_) - m; float e_[16]; \
        _Pragma("unroll") for (int r_ = 0; r_ < 16; ++r_) e_[r_] = ex2(S_[r_] * QK_C + c_); \
        su_ = 0.f; _Pragma("unroll") for (int r_ = 0; r_ < 16; ++r_) su_ += e_[r_]; \
        P0_.x = cvtpk(e_[0], e_[1]); P0_.y = cvtpk(e_[2], e_[3]); P0_.z = cvtpk(e_[4], e_[5]); P0_.w = cvtpk(e_[6], e_[7]); \
        P1_.x = cvtpk(e_[8], e_[9]); P1_.y = cvtpk(e_[10], e_[11]); P1_.z = cvtpk(e_[12], e_[13]); P1_.w = cvtpk(e_[14], e_[15]); } while (0)
    f32x16 o[4];
#pragma unroll
    for (int t = 0; t < 4; ++t)
#pragma unroll
        for (int r = 0; r < 16; ++r) o[t][r] = 0.f;
    float m = M_INIT, l = 0.f;
    {
      const u32x4 a0 = *(const u32x4*)(kvbase + kgo), a1 = *(const u32x4*)(kvbase + (kgo + 32u * 4096u)), a2 = *(const u32x4*)(kvbase + vgo), a3 = *(const u32x4*)(kvbase + (vgo + 4096u));
      DA_LOAD(1);
      const u32x4 b0 = kreg0, b1 = kreg1, b2 = vreg0, b3 = vreg1;
      DA_LOAD(2);
      const u32x4 c0 = kreg0, c1 = kreg1, c2 = vreg0, c3 = vreg1;
      kreg0 = a0; kreg1 = a1; vreg0 = a2; vreg1 = a3; DA_STORE(lds);
      kreg0 = b0; kreg1 = b1; vreg0 = b2; vreg1 = b3; DA_STORE(lds + DA_BUF);
      kreg0 = c0; kreg1 = c1; vreg0 = c2; vreg1 = c3; }
    __syncthreads();
    f32x16 sa, sb;
    bf16x8 kF[4], vF[4], vS[4];
    u32x4 pp0 = {0u, 0u, 0u, 0u}, pp1 = {0u, 0u, 0u, 0u}, pc0, pc1;
    int bcur = 0, bprev = 0, bnext = DA_BUF, bnn = 2 * DA_BUF;
    bool near = (63 >= qblk - 128) && (0 <= qblk + 255); float bc = tbl[0];
    int dtoff = DA_DL_OFF;
    DA_KLD(kF, lds, 0); DA_QKM(sa, kF);
    DA_VLD(vF, lds + bprev, 1, 0);
#define DA_STEP(SC_, SN_, PP0_, PP1_, PC0_, PC1_, Bpv_, subpv_, Bqk_, subqk_, kvbc_, Bv_, subv_) do { \
        if (!((kvbc_) - (q0 + 31) >= 128 || q0 - ((kvbc_) + 31) >= 128)) {     \
            const LAS float* dp_ = (const LAS float*)(lds + dtoff) + ((kvbc_) - q + 320 + 4 * hh); \
            _Pragma("unroll") for (int r_ = 0; r_ < 16; ++r_) SC_[r_] += dp_[(r_ & 3) + 8 * (r_ >> 2)]; }     \
        DA_VLD(vS, Bpv_, subpv_, 1); SB0(); \
        DA_PVM(vF, PP0_); SB0(); \
        DA_KLD(kF, Bqk_, subqk_); SB0(); \
        DA_PVM(vS, PP1_); \
        DA_VLD(vF, Bv_, subv_, 0); SB0(); \
        DA_QKM(SN_, kF); \
        float su_; \
        DA_EXPO(SC_, bc, PC0_, PC1_, su_); \
        if (__builtin_amdgcn_ballot_w64(!(su_ < 1048576.0f)) != 0ull) {     \
            const float sm_ = xh_max(rowmax16(SC_)); \
            DA_RESC(sm_, bc); \
            DA_EXPO(SC_, bc, PC0_, PC1_, su_); } \
        l += su_; } while (0)
#pragma unroll 1
    for (int j = 0; j < 64; ++j) {
        const int j1 = j + 1;
        const bool near1 = (64 * j1 + 63 >= qblk - 128) && (64 * j1 <= qblk + 255);
        const float bc1 = tbl[(64 * j1 > qblk) ? 256 : 0]; const int dtoff1 = (64 * j1 > qblk) ? DA_DR_OFF : DA_DL_OFF;
        DA_STEP(sa, sb, pp0, pp1, pc0, pc1, lds + bprev, 1, lds + bcur, 1, j * 64, lds + bcur, 0);
        __syncthreads();
        DA_STORE(lds + bnn); { const int jl = j + 3 < 64 ? j + 3 : 63; DA_LOAD(jl); }
        DA_STEP(sb, sa, pc0, pc1, pp0, pp1, lds + bcur, 0, lds + bnext, 0, j * 64 + 32, lds + bcur, 1);
        bprev = bcur; bcur = bnext; bnext = bnn; bnn = bprev; near = near1; bc = bc1; dtoff = dtoff1;
    }
    const bf16_t* gp = proj + (rowbase + q) * 4096 + 3584 + h * 128;
    u32x2 gvv[16];
    if (mp == 0) {
#pragma unroll
        for (int i = 0; i < 16; ++i) gvv[i] = *(const u32x2*)(gp + (i >> 2) * 32 + 8 * (i & 3) + 4 * hh);
    }
    DA_VLD(vS, lds + bprev, 1, 1);
    DA_PVM(vF, pp0); DA_PVM(vS, pp1);
    __syncthreads();
#undef DA_EXPO
#undef DA_RESC
#undef DA_STEP
#undef DA_KLD
#undef DA_VLD
#undef DA_QKM
#undef DA_PVM
#undef SB0
#undef DA_LOAD
#undef DA_STORE
    l = xh_sum(l);
    const float sc = (mp == 0 ? 1.0f : lam) * __builtin_amdgcn_rcpf(l);
    LAS float* ex = (LAS float*)lds + (qg * 128) * 32 + l31;
    if (mp == 1) {
#pragma unroll
        for (int dt = 0; dt < 4; ++dt)
#pragma unroll
            for (int r = 0; r < 16; ++r) ex[(dt * 32 + crow(r, hh)) * 32] = o[dt][r] * sc;
    }
    __syncthreads();
    if (mp == 0) {
        float ss = 0.f;
#pragma unroll
        for (int dt = 0; dt < 4; ++dt)
#pragma unroll
            for (int r = 0; r < 16; ++r) { const float v = o[dt][r] * sc - ex[(dt * 32 + crow(r, hh)) * 32]; o[dt][r] = v; ss += v * v; }
        ss = xh_sum(ss);
        const float rn = one_m_li * __builtin_amdgcn_rsqf(ss * (1.0f / 128.0f) + 1e-5f);
        bf16_t* yp = y + (rowbase + q) * 1024 + 512 + h * 128;
#pragma unroll
        for (int dt = 0; dt < 4; ++dt) {
            u32x2 wv[4];
#pragma unroll
            for (int g = 0; g < 4; ++g) {
                const int d = dt * 32 + 8 * g + 4 * hh;
                const u32x2 gv = gvv[dt * 4 + g]; const f32x4 sg = *(const LAS f32x4*)(sgt + d);
                const float g0 = __uint_as_float(gv.x << 16), g1 = __uint_as_float(gv.x & 0xffff0000u), g2 = __uint_as_float(gv.y << 16), g3 = __uint_as_float(gv.y & 0xffff0000u);
                wv[g].x = cvtpk(o[dt][4 * g] * rn * sg[0] * silu(g0), o[dt][4 * g + 1] * rn * sg[1] * silu(g1));
                wv[g].y = cvtpk(o[dt][4 * g + 2] * rn * sg[2] * silu(g2), o[dt][4 * g + 3] * rn * sg[3] * silu(g3));
            }
            store_pair16(yp + dt * 32, hh, wv[0], wv[1]); store_pair16(yp + dt * 32 + 16, hh, wv[2], wv[3]);
        }
    }
}

__device__ __forceinline__ void na_unit(LAS unsigned char* lds, const bf16_t* __restrict__ proj, bf16_t* __restrict__ y, int unit, const float* __restrict__ rpb) {
    int tid = threadIdx.x; asm volatile("" : "+v"(tid));
    const int lane = tid & 63, wid = __builtin_amdgcn_readfirstlane(tid >> 6), l31 = lane & 31, hh = lane >> 5;
    const int rg = unit & 15, bh = unit >> 4, h = bh & 7, b = bh >> 3;
    const size_t rowbase = (size_t)b * 4096;
    const int r0 = rg * 4, rlo = clampi(r0 - 4, 0, 56), rhi = clampi(r0 - 1, 0, 56) + 7, nrows = rhi - rlo + 1;
    LAS float* tbl = (LAS float*)(lds + NA_TBL_OFF);
    __syncthreads();
    { const int dr = tid >> 5, ci = tid & 31; tbl[tid] = (dr < 15 && ci < 31) ? rpb[h * 465 + dr * 31 + ci] * LOG2E : MASKED; }
    { const int c8 = tid & 7, cp = (tid >> 3) & 31, par = tid >> 8;
      const int pos = vpos_of(2 * cp), ch = pos >> 3, sw0 = vsw(8 * c8);
      const unsigned wb = (8 * c8) * 128 + ((pos & 7) >> 1) * 4, wA = wb + ((ch ^ sw0) << 4), wB = wb + ((ch ^ sw0 ^ 4) << 4);
      const bf16_t* gbase = proj + (rowbase + rlo * 64 + 2 * cp) * 4096 + 1024 + h * 64 + c8 * 8;
      u32x4 va[6], vb[6];
#pragma unroll
      for (int k = 0; k < 6; ++k) { const int i = 2 * k + par, ic = i < nrows ? i : nrows - 1; const bf16_t* g = gbase + (size_t)ic * 64 * 4096; va[k] = *(const u32x4*)g; vb[k] = *(const u32x4*)(g + 4096); }
#pragma unroll
      for (int k = 0; k < 6; ++k) { const int i = 2 * k + par; if (i < nrows) { LAS unsigned char* S = lds + i * NA_SLOT;
#pragma unroll
          for (int i2 = 0; i2 < 4; ++i2) { LAS unsigned char* p = S + ((i2 & 1) ? wB : wA) + (2 * i2) * 128;
              *(LAS unsigned*)p = __builtin_amdgcn_perm(vb[k][i2], va[k][i2], 0x05040100u); *(LAS unsigned*)(p + 128) = __builtin_amdgcn_perm(vb[k][i2], va[k][i2], 0x07060302u); } } }
    }
    __syncthreads();
    const int rf = r0 + 2 * (wid >> 2), kblk = wid & 3, c0 = 16 * kblk;
    const int r = rf + (l31 >> 4), c = c0 + (l31 & 15), rs = clampi(r - 4, 0, 56), cs = clampi(c - 8, 0, 48);
    const int rst = clampi(rf - 4, 0, 56), ntile = clampi(rf - 3, 0, 56) - rst + 8;
    const bf16_t* qp = proj + (rowbase + r * 64 + c) * 4096 + h * 64 + hh * 8;
    bf16x8 qf[4];
#pragma unroll
    for (int ks = 0; ks < 4; ++ks) qf[ks] = *(const bf16x8*)(qp + ks * 16);
    unsigned cpk[4];
#pragma unroll
    for (int w = 0; w < 4; ++w) { unsigned v = 0u;
#pragma unroll
        for (int e4 = 0; e4 < 4; ++e4) { const int kcol = c0 - 8 + crow(4 * w + e4, hh); const bool valid = (kcol >= cs) && (kcol <= cs + 15);
            v |= (unsigned)(valid ? kcol - c + 15 : 31) << (8 * e4); }
        cpk[w] = v; }
    f32x16 o[2];
#pragma unroll
    for (int t = 0; t < 2; ++t)
#pragma unroll
        for (int rr = 0; rr < 16; ++rr) o[t][rr] = 0.f;
    float m = M_INIT, l = 0.f;
    const bf16_t* kbase = proj + (rowbase + rst * 64 + clampi(c0 - 8 + l31, 0, 63)) * 4096 + 512 + h * 64 + hh * 8;
#define NA_KPTR(t_) (kbase + (size_t)(t_) * 64 * 4096)
    const unsigned vrd = (unsigned)(l31 * 128) ^ (unsigned)((hh ^ vsw(l31)) << 4);
    const unsigned xa0 = (unsigned)(2 * clampi(kblk - 1, 0, 3)) << 4, xb0 = (unsigned)(2 * kblk) << 4, xa1 = xb0, xb1 = (unsigned)(2 * clampi(kblk + 1, 0, 3)) << 4;
    bf16x8 kq[4][4];
#pragma unroll
    for (int t = 0; t < 3; ++t)
#pragma unroll
        for (int ks = 0; ks < 4; ++ks) kq[t][ks] = *(const bf16x8*)(NA_KPTR(t) + ks * 16);
#pragma unroll
    for (int t = 0; t < 9; ++t) {
        if (t < 8 || ntile == 9) {
        { const int tl = (t + 3 < ntile) ? t + 3 : ntile - 1;
#pragma unroll
          for (int ks = 0; ks < 4; ++ks) kq[(t + 3) & 3][ks] = *(const bf16x8*)(NA_KPTR(tl) + ks * 16); }
        const int krow = rst + t;
        const LAS float* trow = tbl + (((krow >= rs) && (krow <= rs + 7)) ? krow - r + 7 : 15) * 32;
        const unsigned vslot = (unsigned)(uintptr_t)(lds + (krow - rlo) * NA_SLOT) + vrd;
        f32x16 s;
        { f32x16 z;
#pragma unroll
          for (int rr = 0; rr < 16; ++rr) z[rr] = 0.f;
          s = mfma32(kq[t & 3][0], qf[0], z); }
#pragma unroll
        for (int ks = 1; ks < 4; ++ks) s = mfma32(kq[t & 3][ks], qf[ks], s);
#pragma unroll
        for (int rr = 0; rr < 16; ++rr) { const unsigned ci = (cpk[rr >> 2] >> (8 * (rr & 3))) & 0xffu; s[rr] = s[rr] * QK_C + trow[ci]; }
        u32x4 p0, p1;
        softmax_step<2>(s, m, l, o, p0, p1);
#pragma unroll
        for (int dt = 0; dt < 2; ++dt) {
            const unsigned dx = (unsigned)((dt & 1) << 2) << 4, db = dt * 32 * 128;
            const u32x2 a0 = *(const LAS u32x2*)(uintptr_t)((vslot ^ xa0 ^ dx) + db + 8), b0 = *(const LAS u32x2*)(uintptr_t)((vslot ^ xb0 ^ dx) + db);
            const u32x2 a1 = *(const LAS u32x2*)(uintptr_t)((vslot ^ xa1 ^ dx) + db + 8), b1 = *(const LAS u32x2*)(uintptr_t)((vslot ^ xb1 ^ dx) + db);
            const u32x4 v0 = {a0.x, a0.y, b0.x, b0.y}, v1 = {a1.x, a1.y, b1.x, b1.y};
            o[dt] = mfma32(__builtin_bit_cast(bf16x8, v0), __builtin_bit_cast(bf16x8, p0), o[dt]);
            o[dt] = mfma32(__builtin_bit_cast(bf16x8, v1), __builtin_bit_cast(bf16x8, p1), o[dt]);
        }
        }
    }
#undef NA_KPTR
    l = xh_sum(l);
    const float il = __builtin_amdgcn_rcpf(l);
    const size_t tok = rowbase + r * 64 + c;
    const bf16_t* gp = proj + tok * 4096 + 1536 + h * 64;
    bf16_t* yp = y + tok * 1024 + h * 64;
#pragma unroll
    for (int dt = 0; dt < 2; ++dt) {
        u32x2 wv[4];
#pragma unroll
        for (int g = 0; g < 4; ++g) {
            const int d = dt * 32 + 8 * g + 4 * hh;
            const u32x2 gv = *(const u32x2*)(gp + d);
            const float g0 = __uint_as_float(gv.x << 16), g1 = __uint_as_float(gv.x & 0xffff0000u), g2 = __uint_as_float(gv.y << 16), g3 = __uint_as_float(gv.y & 0xffff0000u);
            wv[g].x = cvtpk(o[dt][4 * g] * il * silu(g0), o[dt][4 * g + 1] * il * silu(g1));
            wv[g].y = cvtpk(o[dt][4 * g + 2] * il * silu(g2), o[dt][4 * g + 3] * il * silu(g3));
        }
        store_pair16(yp + dt * 32, hh, wv[0], wv[1]); store_pair16(yp + dt * 32 + 16, hh, wv[2], wv[3]);
    }
}
}
typedef unsigned short bf16_t;
constexpr int M_TOK = 65536, DMODEL = 1024, NIN = 4096, DEPTH = 4;
constexpr size_t MiB = 1u << 20;
constexpr size_t WS_WIN = 0, WS_WOUT = 32 * MiB, WS_SSQ = 40 * MiB, WS_XB = 64 * MiB, WS_Y = 192 * MiB, WS_PROJ = 320 * MiB, WS_CTL = 832 * MiB, CTL_BYTES = 16384, WS_END = 833 * MiB;
constexpr int LDS_BYTES = 131072 + 256, MISC_OFF = 131072;
#ifndef MK_N_LAUNCHES
#define MK_N_LAUNCHES 1
#endif

__device__ __forceinline__ float wave_sum(float v) {
#pragma unroll
    for (int o = 1; o < 64; o <<= 1) v += __shfl_xor(v, o);
    return v;
}
__device__ __forceinline__ void p0_transpose_item(const float* W, int K, int N, bf16_t* WT, const float* gk, LAS float* scr, int item, int lane) {
    const int nblk = N / 32, kb = item / nblk, nb = item % nblk, k0 = 64 * kb, n0 = 32 * nb;
    float wv[32];
#pragma unroll
    for (int i = 0; i < 32; ++i) { const int kk = 2 * i + (lane >> 5); wv[i] = W[(size_t)(k0 + kk) * N + n0 + (lane & 31)]; }
#pragma unroll
    for (int i = 0; i < 32; ++i) { const int kk = 2 * i + (lane >> 5); const float g = gk ? gk[k0 + kk] : 1.0f; scr[kk * 33 + (lane & 31)] = wv[i] * g; }
    asm volatile("s_waitcnt lgkmcnt(0)" ::: "memory");
    const int c = lane & 7;
#pragma unroll
    for (int j = 0; j < 4; ++j) { const int n = (lane >> 3) + 8 * j; const LAS float* s = scr + (8 * c) * 33 + n;
        att::u32x4 o; o.x = pg8::cvtpk(s[0 * 33], s[1 * 33]); o.y = pg8::cvtpk(s[2 * 33], s[3 * 33]); o.z = pg8::cvtpk(s[4 * 33], s[5 * 33]); o.w = pg8::cvtpk(s[6 * 33], s[7 * 33]);
        *(att::u32x4*)(WT + (size_t)(n0 + n) * K + k0 + 8 * c) = o; }
    asm volatile("s_waitcnt lgkmcnt(0)" ::: "memory");
}

#define XB_TMO      128
#define XB_XCNT(j)  (256  + 64 * (j))
#define XB_XSUB(j)  (1280 + 64 * (j))
#define XB_XGEN(j)  (2304 + 64 * (j))
#define XB_TOP      3328
#define XB_TOPGEN   3392
#define XCD_BAR_WORDS 3456
#define XB_SPIN_CAP (1u << 18)

__device__ __forceinline__ unsigned xb_ld(unsigned* p)              { return __hip_atomic_load(p, __ATOMIC_RELAXED, __HIP_MEMORY_SCOPE_AGENT); }
__device__ __forceinline__ unsigned xb_add(unsigned* p, unsigned v) { return __hip_atomic_fetch_add(p, v, __ATOMIC_RELAXED, __HIP_MEMORY_SCOPE_AGENT); }
__device__ __forceinline__ unsigned xb_xcc_id() { return (unsigned)__builtin_amdgcn_s_getreg((3 << 11) | 20) & 0xFu; }
#define XB_SPIN(cond, bar) do { unsigned _sp = 0; while (cond) { __builtin_amdgcn_s_sleep(1); \
    if ((++_sp & 255u) == 0u) { if (xb_ld(&(bar)[XB_TMO])) break; if (_sp > XB_SPIN_CAP) { atomicAdd(&(bar)[XB_TMO], 1u); break; } } } } while (0)

struct XcdBarrier {
    unsigned* bar; unsigned x;
    volatile LAS unsigned* st;
};

__device__ __forceinline__ XcdBarrier xcd_barrier_post(unsigned* bar, volatile LAS unsigned* st) {
    XcdBarrier b; b.bar = bar; b.x = xb_xcc_id(); b.st = st;
    if (threadIdx.x == 0) (void)xb_add(&bar[XB_XCNT(b.x)], 1u);
    return b;
}
__device__ __forceinline__ void xcd_barrier_complete(unsigned* bar, unsigned x, unsigned& nloc, unsigned& nx) {
    const unsigned G = gridDim.x * gridDim.y * gridDim.z;
    unsigned sum, cnt, mine, sp = 0u;
    for (;;) {
        sum = 0u; cnt = 0u; mine = 0u;
#pragma unroll
        for (unsigned j = 0; j < 16; ++j) { const unsigned c = xb_ld(&bar[XB_XCNT(j)]); sum += c; cnt += (c > 0u) ? 1u : 0u; mine = (j == x) ? c : mine; }
        if (sum == G) break;
        __builtin_amdgcn_s_sleep(1);
        if ((++sp & 255u) == 0u) { if (xb_ld(&bar[XB_TMO])) break; if (sp > XB_SPIN_CAP) { atomicAdd(&bar[XB_TMO], 1u); break; } }
    }
    nloc = mine > 0u ? mine : 1u; nx = cnt > 0u ? cnt : 1u;
}

__device__ __forceinline__ void xcd_barrier(const XcdBarrier& b) {
    asm volatile("s_waitcnt vmcnt(0)" ::: "memory");
    __syncthreads();
    if (threadIdx.x == 0) {
        unsigned* bar = b.bar;
        __builtin_amdgcn_s_waitcnt(0);
        unsigned nloc = b.st[0], nx = b.st[1];
        if (nloc == 0u) { xcd_barrier_complete(bar, b.x, nloc, nx); b.st[0] = nloc; b.st[1] = nx; }
        const unsigned old = xb_add(&bar[XB_XSUB(b.x)], 1u);
        const unsigned gen = old / nloc;
        if (old + 1u == (gen + 1u) * nloc) {
            __builtin_amdgcn_fence(__ATOMIC_RELEASE, "agent");
            asm volatile("s_waitcnt vmcnt(0)" ::: "memory");
            const unsigned og = xb_add(&bar[XB_TOP], 1u);
            const unsigned tg = og / nx;
            if (og + 1u == (tg + 1u) * nx) xb_add(&bar[XB_TOPGEN], 1u);
            else XB_SPIN(xb_ld(&bar[XB_TOPGEN]) == tg, bar);
            __builtin_amdgcn_fence(__ATOMIC_ACQUIRE, "agent");
            xb_add(&bar[XB_XGEN(b.x)], 1u);
            asm volatile("s_waitcnt vmcnt(0)" ::: "memory");
        } else {
            XB_SPIN(xb_ld(&bar[XB_XGEN(b.x)]) == gen, bar);
            __builtin_amdgcn_fence(__ATOMIC_ACQUIRE, "agent");
            asm volatile("s_waitcnt vmcnt(0)" ::: "memory");
        }
    }
    __syncthreads();
}

struct Args { const float* x; const float* norm_g; const float* w_in; const float* rpb; const float* lq1; const float* lk1; const float* lq2; const float* lk2;
              const float* subg; const float* t5; const float* w_out; const float* final_g; float* out; unsigned char* ws; long long ph_lo, ph_hi; };

constexpr int N_PHASES = 14;
__global__ void __launch_bounds__(512, 2) fwd_megakernel(Args a) {
    extern __shared__ __attribute__((aligned(16))) unsigned char lds_raw[];
    LAS unsigned char* lds = (LAS unsigned char*)lds_raw;
    const int G = gridDim.x, bx = blockIdx.x, vcu = (G % 8 == 0) ? (bx % 8) * (G / 8) + bx / 8 : bx;
    const int NGW = G * 8;
    unsigned char* ws = a.ws;
    bf16_t* WinT = (bf16_t*)(ws + WS_WIN); bf16_t* WoutT = (bf16_t*)(ws + WS_WOUT); float* ssq = (float*)(ws + WS_SSQ);
    bf16_t* xb = (bf16_t*)(ws + WS_XB); bf16_t* yb = (bf16_t*)(ws + WS_Y); bf16_t* proj = (bf16_t*)(ws + WS_PROJ);
    const int lo = (int)a.ph_lo, hi = (int)a.ph_hi;
#define IN(k) (lo <= (k) && (k) < hi)
    { int t_ = threadIdx.x; if (t_ < 64) ((volatile LAS unsigned*)(lds + MISC_OFF))[t_] = 0u; __syncthreads(); }
    const XcdBarrier xbar = xcd_barrier_post((unsigned*)(ws + WS_CTL), (volatile LAS unsigned*)(lds + MISC_OFF) + 8);
#define SEAM(k) do { if (IN(k) && IN((k) + 1)) { if ((k) == 0) cg::this_grid().sync(); else xcd_barrier(xbar); } } while (0)

    if (IN(0)) {
        int t0 = threadIdx.x; asm volatile("" : "+v"(t0)); const int lane = t0 & 63, wid = __builtin_amdgcn_readfirstlane(t0 >> 6), gw = bx * 8 + wid;
        LAS float* scr = (LAS float*)(lds + wid * 16384);
        constexpr int I_IN = (DMODEL / 64) * (NIN / 32), I_OUT = (DMODEL / 64) * (DMODEL / 32), I_L = I_IN + I_OUT;
        for (int it = gw; it < DEPTH * I_L; it += NGW) {
            const int l = it / I_L, r = it % I_L;
            if (r < I_IN) p0_transpose_item(a.w_in + (size_t)l * DMODEL * NIN, DMODEL, NIN, WinT + (size_t)l * NIN * DMODEL, a.norm_g + l * DMODEL, scr, r, lane);
            else p0_transpose_item(a.w_out + (size_t)l * DMODEL * DMODEL, DMODEL, DMODEL, WoutT + (size_t)l * DMODEL * DMODEL, nullptr, scr, r - I_IN, lane);
        }
        for (int m = gw; m < M_TOK; m += 2 * NGW) {
            const int mb = (m + NGW < M_TOK) ? m + NGW : m;
            const att::f32x4* xr = (const att::f32x4*)(a.x + (size_t)m * DMODEL) + lane; const att::f32x4* xq = (const att::f32x4*)(a.x + (size_t)mb * DMODEL) + lane;
            att::f32x4 v[4], w4[4]; float s = 0.f, s2 = 0.f;
#pragma unroll
            for (int j = 0; j < 4; ++j) { v[j] = __builtin_nontemporal_load(xr + 64 * j); w4[j] = __builtin_nontemporal_load(xq + 64 * j); }
#pragma unroll
            for (int j = 0; j < 4; ++j) { s += (v[j][0] * v[j][0] + v[j][1] * v[j][1]) + (v[j][2] * v[j][2] + v[j][3] * v[j][3]); s2 += (w4[j][0] * w4[j][0] + w4[j][1] * w4[j][1]) + (w4[j][2] * w4[j][2] + w4[j][3] * w4[j][3]); }
            s = wave_sum(s); s2 = wave_sum(s2);
            att::u32x2* o8 = (att::u32x2*)(xb + (size_t)m * DMODEL) + lane; att::u32x2* o9 = (att::u32x2*)(xb + (size_t)mb * DMODEL) + lane;
#pragma unroll
            for (int j = 0; j < 4; ++j) { att::u32x2 w; w.x = pg8::cvtpk(v[j][0], v[j][1]); w.y = pg8::cvtpk(v[j][2], v[j][3]); o8[64 * j] = w;
                                          att::u32x2 y; y.x = pg8::cvtpk(w4[j][0], w4[j][1]); y.y = pg8::cvtpk(w4[j][2], w4[j][3]); o9[64 * j] = y; }
            if (lane < 16) { ssq[(size_t)m * 16 + lane] = (lane == 0) ? s : 0.f; ssq[(size_t)mb * 16 + lane] = (lane == 0) ? s2 : 0.f; }
        }
    }
    SEAM(0);
    for (int l = 0; l < DEPTH; ++l) {
        if (IN(1 + 3 * l)) {
            pg8::Gemm g{xb, WinT + (size_t)l * NIN * DMODEL, M_TOK, NIN, DMODEL}; pg8::StaticOrder S; S.init(M_TOK, NIN, G, bx);
            pg8::EpiProj E{proj, ssq, NIN};
            pg8::gemm_phase<pg8::EpiProj, pg8::StaticOrder, true, true>(lds, g, S, E);
        }
        SEAM(1 + 3 * l);
        if (IN(2 + 3 * l)) {
            int lz = l, lanez = threadIdx.x; asm volatile("" : "+s"(lz), "+v"(lanez)); lanez &= 63;
            const float li = 0.8f - 0.6f * expf(-0.3f * (float)lz);
            const float p1 = wave_sum(a.lq1[lz * 64 + lanez] * a.lk1[lz * 64 + lanez]), p2 = wave_sum(a.lq2[lz * 64 + lanez] * a.lk2[lz * 64 + lanez]);
            const float lam = __uint_as_float(__builtin_amdgcn_readfirstlane(__float_as_uint(expf(p1) - expf(p2) + li)));
            const int vcuz = vcu + (lz - l);
            for (int u = vcuz; u < 2048; u += G) att::da_unit(lds, proj, yb, u, a.t5, lam, __uint_as_float(__builtin_amdgcn_readfirstlane(__float_as_uint(1.0f - li))), a.subg + lz * 128);
            for (int u = vcuz; u < 2048; u += G) att::na_unit(lds, proj, yb, u, a.rpb + (size_t)lz * 8 * 465);
            __syncthreads();
        }
        SEAM(2 + 3 * l);
        if (IN(3 + 3 * l)) {
            pg8::Gemm g{yb, WoutT + (size_t)l * DMODEL * DMODEL, M_TOK, DMODEL, DMODEL}; pg8::StaticOrder S; S.init(M_TOK, DMODEL, G, bx);
            pg8::EpiOut E{xb, ssq};
            pg8::gemm_phase<pg8::EpiOut, pg8::StaticOrder, true, true>(lds, g, S, E);
        }
        SEAM(3 + 3 * l);
    }
    if (IN(13)) {
        int t13 = threadIdx.x; asm volatile("" : "+v"(t13)); const int lane = t13 & 63, gw = bx * 8 + (t13 >> 6);
        att::f32x4 fg[4];
#pragma unroll
        for (int j = 0; j < 4; ++j) fg[j] = *((const att::f32x4*)a.final_g + lane + 64 * j);
        for (int m = gw; m < M_TOK; m += 2 * NGW) {
            const int mb = (m + NGW < M_TOK) ? m + NGW : m;
            const att::u32x2* xr = (const att::u32x2*)(xb + (size_t)m * DMODEL) + lane; const att::u32x2* xq = (const att::u32x2*)(xb + (size_t)mb * DMODEL) + lane;
            att::u32x2 ra[4], rb[4];
#pragma unroll
            for (int j = 0; j < 4; ++j) { ra[j] = xr[64 * j]; rb[j] = xq[64 * j]; }
            att::f32x4 v[4], w4[4]; float s = 0.f, s2 = 0.f;
#pragma unroll
            for (int j = 0; j < 4; ++j) {
                v[j][0] = __uint_as_float(ra[j].x << 16); v[j][1] = __uint_as_float(ra[j].x & 0xffff0000u); v[j][2] = __uint_as_float(ra[j].y << 16); v[j][3] = __uint_as_float(ra[j].y & 0xffff0000u);
                w4[j][0] = __uint_as_float(rb[j].x << 16); w4[j][1] = __uint_as_float(rb[j].x & 0xffff0000u); w4[j][2] = __uint_as_float(rb[j].y << 16); w4[j][3] = __uint_as_float(rb[j].y & 0xffff0000u);
                s += (v[j][0] * v[j][0] + v[j][1] * v[j][1]) + (v[j][2] * v[j][2] + v[j][3] * v[j][3]); s2 += (w4[j][0] * w4[j][0] + w4[j][1] * w4[j][1]) + (w4[j][2] * w4[j][2] + w4[j][3] * w4[j][3]); }
            s = wave_sum(s); s2 = wave_sum(s2);
            const float rs = 1.0f / sqrtf(s * (1.0f / 1024.0f) + 1e-6f), rs2 = 1.0f / sqrtf(s2 * (1.0f / 1024.0f) + 1e-6f);
            att::f32x4* orow = (att::f32x4*)(a.out + (size_t)m * DMODEL) + lane; att::f32x4* orow2 = (att::f32x4*)(a.out + (size_t)mb * DMODEL) + lane;
#pragma unroll
            for (int j = 0; j < 4; ++j) { __builtin_nontemporal_store(v[j] * rs * fg[j], orow + 64 * j); __builtin_nontemporal_store(w4[j] * rs2 * fg[j], orow2 + 64 * j); }
        }
    }
#undef IN
#undef SEAM
}

extern "C" void kernel_launch(void* const* d_in, const int* in_sizes, int n_in, void* d_out, int out_size, void* d_ws, size_t ws_size, hipStream_t stream) {
    static int grid = 0;
    if (grid == 0) {
        if (n_in != 12 || in_sizes[0] != M_TOK * DMODEL || out_size != M_TOK * DMODEL || ws_size < WS_END) { fprintf(stderr, "kernel_launch: unexpected shapes (n_in %d, ws %zu)\n", n_in, ws_size); grid = -1; return; }
        int dev = 0, cus = 0, per_cu = 0;
        hipGetDevice(&dev); hipDeviceGetAttribute(&cus, hipDeviceAttributeMultiprocessorCount, dev);
        if (hipFuncSetAttribute((const void*)fwd_megakernel, hipFuncAttributeMaxDynamicSharedMemorySize, LDS_BYTES) != hipSuccess) { fprintf(stderr, "kernel_launch: hipFuncSetAttribute failed\n"); grid = -1; return; }
        if (hipOccupancyMaxActiveBlocksPerMultiprocessor(&per_cu, (const void*)fwd_megakernel, 512, LDS_BYTES) != hipSuccess || per_cu < 1) { fprintf(stderr, "kernel_launch: occupancy query says %d\n", per_cu); per_cu = 1; }
        (void)hipGetLastError();
        grid = cus * 1;
    }
    if (grid < 0) return;
    if (hipMemsetAsync((char*)d_ws + WS_CTL, 0, CTL_BYTES, stream) != hipSuccess) { fprintf(stderr, "kernel_launch: hipMemsetAsync failed\n"); return; }
    Args a{};
    a.x = (const float*)d_in[0]; a.norm_g = (const float*)d_in[1]; a.w_in = (const float*)d_in[2]; a.rpb = (const float*)d_in[3];
    a.lq1 = (const float*)d_in[4]; a.lk1 = (const float*)d_in[5]; a.lq2 = (const float*)d_in[6]; a.lk2 = (const float*)d_in[7];
    a.subg = (const float*)d_in[8]; a.t5 = (const float*)d_in[9]; a.w_out = (const float*)d_in[10]; a.final_g = (const float*)d_in[11];
    a.out = (float*)d_out; a.ws = (unsigned char*)d_ws;
#if MK_N_LAUNCHES == 1
    a.ph_lo = 0; a.ph_hi = N_PHASES;
    void* args[] = {&a};
    const hipError_t e = hipLaunchCooperativeKernel((const void*)fwd_megakernel, dim3(grid), dim3(512), args, LDS_BYTES, stream);
    if (e != hipSuccess) fprintf(stderr, "kernel_launch: cooperative launch failed: %s (grid %d)\n", hipGetErrorString(e), grid);
#else
    for (int p = 0; p < N_PHASES; ++p) { a.ph_lo = p; a.ph_hi = p + 1; hipLaunchKernelGGL(fwd_megakernel, dim3(grid), dim3(512), LDS_BYTES, stream, a); }
#endif
}
```

```cpp
#include <hip/hip_runtime.h>
#include <hip/hip_cooperative_groups.h>
#include <cstdio>
#include <cstdint>
namespace cg = cooperative_groups;
namespace pg8 {
#define PG8_LAS __attribute__((address_space(3)))
typedef unsigned short bf16_t;
typedef short bf16x8 __attribute__((ext_vector_type(8)));
typedef float f32x4 __attribute__((ext_vector_type(4)));
typedef unsigned u32x4 __attribute__((ext_vector_type(4)));
constexpr int BM = 256, BK = 64, HALF = 128, HTB = HALF * BK * 2  , STAGE_BYTES = 8 * HTB, NXCD = 8, WGM = 8;

__host__ __device__ __forceinline__ int lds_byte(int r, int c) { const int st = (r >> 4) * 2 + (c >> 5), rr = r & 15, cc = c & 31, ob = rr * 64 + cc * 2; return st * 1024 + (ob ^ (((ob >> 9) & 1) << 5)); }
__host__ __device__ __forceinline__ void stage_rc(int b, int& R, int& C) { const int st = b / 1024, sb = b % 1024, swz = sb ^ (((sb >> 9) & 1) << 5); R = (st >> 1) * 16 + swz / 64; C = (st & 1) * 32 + (swz % 64) / 2; }
__host__ __device__ __forceinline__ int perm32(int rho) { const int n = rho >> 4, i = rho & 15; return 8 * (i >> 2) + 4 * n + (i & 3); }

struct Unit { int pm, pn; };
struct Gemm { const bf16_t* A; const bf16_t* Bt; int M, N, K; };

struct StaticOrder {
    int nM, nN, nwg, G, c;
    __host__ __device__ void init(int M, int N, int G_, int c_) { nM = M / BM; nN = N / BM; nwg = nM * nN; G = G_; c = c_; }
    __host__ __device__ bool next(int i, Unit& u) const {
        const long L = (long)i * G + c; if (L >= nwg) return false;
        int wgid = (int)L; { const int q = nwg / NXCD, r = nwg % NXCD, xcd = wgid % NXCD, off = wgid / NXCD; wgid = (xcd < r ? xcd * (q + 1) : r * (q + 1) + (xcd - r) * q) + off; }
        const int nig = WGM * nN, gid = wgid / nig, fm = gid * WGM, gsz = (nM - fm) < WGM ? (nM - fm) : WGM;
        u.pm = fm + ((wgid % nig) % gsz); u.pn = (wgid % nig) / gsz; return true;
    }
    __device__ __forceinline__ void a_ready(const Unit&) const {}
    __device__ __forceinline__ void done(const Unit&) const {}
};

typedef float f32x2_t __attribute__((ext_vector_type(2))); typedef __bf16 bf16x2_t __attribute__((ext_vector_type(2)));
__device__ __forceinline__ unsigned cvtpk(float lo, float hi) { f32x2_t v = {lo, hi}; bf16x2_t b = __builtin_convertvector(v, bf16x2_t); return __builtin_bit_cast(unsigned, b); }
typedef unsigned u32x2 __attribute__((ext_vector_type(2)));
__device__ __forceinline__ float sum_rows4(float v) {
    auto a = __builtin_amdgcn_permlane16_swap(__float_as_uint(v), __float_as_uint(v), false, false); const float s = __uint_as_float(a[0]) + __uint_as_float(a[1]);
    auto b = __builtin_amdgcn_permlane32_swap(__float_as_uint(s), __float_as_uint(s), false, false); return __uint_as_float(b[0]) + __uint_as_float(b[1]);
}

struct EpiProj {
    static constexpr bool PERM = true, AFTER_DRAIN = false;
    bf16_t* O; const float* ssq; int ldc;
    __device__ __forceinline__ void operator()(const f32x4 (&acc)[2][2][4][2], const Unit& u, int wr, int wc, int fr, int fq) const {
        const int row0 = u.pm * BM + wr * 64 + fr; const int col0 = u.pn * BM + wc * 32 + 8 * fq;
#pragma unroll
        for (int ai = 0; ai < 2; ++ai)
#pragma unroll
            for (int m = 0; m < 4; ++m) {
                const int row = row0 + ai * HALF + m * 16;
                const f32x4 a = *((const f32x4*)(ssq + (size_t)row * 16) + fq);
                float tot = (a[0] + a[1]) + (a[2] + a[3]);
                tot = sum_rows4(tot);
                const float rs = __builtin_amdgcn_rsqf(tot * (1.0f / 1024.0f) + 1e-6f);
                bf16_t* rowp = O + (size_t)row * ldc + col0;
#pragma unroll
                for (int bj = 0; bj < 2; ++bj) { const f32x4 v0 = acc[ai][bj][m][0] * rs, v1 = acc[ai][bj][m][1] * rs;
                    u32x4 w; w.x = cvtpk(v0[0], v0[1]); w.y = cvtpk(v0[2], v0[3]); w.z = cvtpk(v1[0], v1[1]); w.w = cvtpk(v1[2], v1[3]);
                    *(u32x4*)(rowp + bj * HALF) = w; }
                asm volatile("" ::: "memory"); }
    }
};
struct EpiOut {
    static constexpr bool PERM = true, AFTER_DRAIN = false;
    bf16_t* xb; float* ssq;
    __device__ __forceinline__ void operator()(const f32x4 (&acc)[2][2][4][2], const Unit& u, int wr, int wc, int fr, int fq) const {
        const int col0 = u.pn * BM + wc * 32 + 8 * fq;
#pragma unroll
        for (int ai = 0; ai < 2; ++ai)
#pragma unroll
            for (int m = 0; m < 4; ++m) {
                const int row = u.pm * BM + ai * HALF + wr * 64 + m * 16 + fr; const size_t off = (size_t)row * 1024 + col0;
                float q = 0.f;
#pragma unroll
                for (int bj = 0; bj < 2; ++bj) { u32x4* p = (u32x4*)(xb + off + bj * HALF); const u32x4 b = *p;
                    f32x4 o0, o1; o0[0] = __uint_as_float(b.x << 16); o0[1] = __uint_as_float(b.x & 0xffff0000u); o0[2] = __uint_as_float(b.y << 16); o0[3] = __uint_as_float(b.y & 0xffff0000u);
                    o1[0] = __uint_as_float(b.z << 16); o1[1] = __uint_as_float(b.z & 0xffff0000u); o1[2] = __uint_as_float(b.w << 16); o1[3] = __uint_as_float(b.w & 0xffff0000u);
                    o0 = o0 + acc[ai][bj][m][0]; o1 = o1 + acc[ai][bj][m][1];
                    q += ((o0[0] * o0[0] + o0[1] * o0[1]) + (o0[2] * o0[2] + o0[3] * o0[3])) + ((o1[0] * o1[0] + o1[1] * o1[1]) + (o1[2] * o1[2] + o1[3] * o1[3]));
                    u32x4 w; w.x = cvtpk(o0[0], o0[1]); w.y = cvtpk(o0[2], o0[3]); w.z = cvtpk(o1[0], o1[1]); w.w = cvtpk(o1[2], o1[3]); *p = w; }
                q = sum_rows4(q);
                if (fq == 0) ssq[(size_t)row * 16 + u.pn * 4 + wc] = q;
                asm volatile("" ::: "memory");
            }
    }
};
template <class Epi, class Sched, bool ALIGN_EPI = false, bool SP2 = false>
__device__ __forceinline__ void gemm_phase(PG8_LAS unsigned char* lds, const Gemm g, const Sched& S, const Epi& E) {
    int tid = threadIdx.x; asm volatile("" : "+v"(tid));
    const int wid = __builtin_amdgcn_readfirstlane(tid >> 6), lane = tid & 63, wr = wid >> 2, wc = wid & 3, fr = lane & 15, fq = lane >> 4;
    const int K = g.K, nt = K / BK;
    unsigned voffA[2], voffB[2];
#pragma unroll
    for (int i = 0; i < 2; ++i) { int R, C; stage_rc(tid * 16 + i * 8192, R, C); const int Rb = Epi::PERM ? ((R & ~31) + perm32(R & 31)) : R;
        voffA[i] = (unsigned)(R * K + C) * 2u; voffB[i] = (unsigned)(Rb * K + C) * 2u; }
    const size_t kstep = (size_t)(BK * 2);
    const size_t hstep = (size_t)HALF * K * 2;
    const size_t tstep = 2 * hstep;
    const unsigned ldsw = (unsigned)wid * 1024u;
    const int aoff = lds_byte(wr * 64 + fr, fq * 8), boff = lds_byte(wc * 32 + fr, fq * 8);
#define PG8_SA(b, h) (((b) * 2 + (h)) * HTB)
#define PG8_SB(b, h) ((4 + (b) * 2 + (h)) * HTB)
#define PG8_STAGE(bufoff, gbase, voff) do { _Pragma("unroll") for (int _i = 0; _i < 2; ++_i) \
        __builtin_amdgcn_global_load_lds((const unsigned*)((const char*)(gbase) + (voff)[_i]), (PG8_LAS unsigned*)(lds + (bufoff) + ldsw + _i * 8192), 16, 0, 0); } while (0)
#define PG8_LDA(dst, b, h) do { _Pragma("unroll") for (int m = 0; m < 4; ++m) _Pragma("unroll") for (int k = 0; k < 2; ++k) dst[m][k] = *(const PG8_LAS bf16x8*)(lds + PG8_SA(b, h) + aoff + m * 2048 + k * 1024); } while (0)
#define PG8_LDB(dst, b, h) do { _Pragma("unroll") for (int n = 0; n < 2; ++n) _Pragma("unroll") for (int k = 0; k < 2; ++k) dst[n][k] = *(const PG8_LAS bf16x8*)(lds + PG8_SB(b, h) + boff + n * 2048 + k * 1024); } while (0)
#define PG8_MMA(ai, bj, At, Bt) do { __builtin_amdgcn_s_setprio(1); _Pragma("unroll") for (int m = 0; m < 4; ++m) _Pragma("unroll") for (int n = 0; n < 2; ++n) _Pragma("unroll") for (int k = 0; k < 2; ++k) \
        acc[ai][bj][m][n] = __builtin_amdgcn_mfma_f32_16x16x32_bf16(Bt[n][k], At[m][k], acc[ai][bj][m][n], 0, 0, 0); __builtin_amdgcn_s_setprio(0); } while (0)
#define PG8_WAIT_V(n) asm volatile("s_waitcnt vmcnt(" #n ")" ::: "memory")
#define PG8_WAIT_L(n) asm volatile("s_waitcnt lgkmcnt(" #n ")" ::: "memory")
#define PG8_BAR __builtin_amdgcn_s_barrier()
#define PG8_SCHED __builtin_amdgcn_sched_barrier(0)
    Unit cur, nxt; int ui = 0;
    if (!S.next(0, cur)) return;
    f32x4 acc[2][2][4][2];
#pragma unroll
    for (int a = 0; a < 2; ++a)
#pragma unroll
        for (int b = 0; b < 2; ++b)
#pragma unroll
            for (int m = 0; m < 4; ++m)
#pragma unroll
                for (int n = 0; n < 2; ++n) acc[a][b][m][n] = (f32x4){0.f, 0.f, 0.f, 0.f};
    bf16x8 At[4][2], B0[2][2], B1[2][2];
    const char* cA = (const char*)g.A + (size_t)cur.pm * tstep; const char* cB = (const char*)g.Bt + (size_t)cur.pn * tstep;
    S.a_ready(cur);
    if constexpr (SP2) {
        PG8_STAGE(PG8_SB(0, 0), cB, voffB); PG8_STAGE(PG8_SB(0, 1), cB + hstep, voffB); PG8_STAGE(PG8_SA(0, 0), cA, voffA); PG8_STAGE(PG8_SA(0, 1), cA + hstep, voffA);
        if (wr == 1) PG8_BAR;
        PG8_WAIT_V(2); PG8_BAR;
        PG8_STAGE(PG8_SB(1, 0), cB + kstep, voffB); PG8_STAGE(PG8_SA(1, 0), cA + kstep, voffA); PG8_STAGE(PG8_SB(1, 1), cB + hstep + kstep, voffB);
        PG8_WAIT_V(6); PG8_BAR;
    } else {
        PG8_STAGE(PG8_SB(0, 0), cB, voffB); PG8_STAGE(PG8_SA(0, 0), cA, voffA); PG8_STAGE(PG8_SB(0, 1), cB + hstep, voffB); PG8_STAGE(PG8_SA(0, 1), cA + hstep, voffA);
        if (wr == 1) PG8_BAR;
        PG8_WAIT_V(4); PG8_BAR;
        PG8_STAGE(PG8_SB(1, 0), cB + kstep, voffB); PG8_STAGE(PG8_SA(1, 0), cA + kstep, voffA); PG8_STAGE(PG8_SB(1, 1), cB + hstep + kstep, voffB);
        PG8_WAIT_V(6); PG8_BAR;
    }
    for (;;) {
        const bool has_next = S.next(ui + 1, nxt);
        const char* nA = has_next ? (const char*)g.A + (size_t)nxt.pm * tstep : cA; const char* nB = has_next ? (const char*)g.Bt + (size_t)nxt.pn * tstep : cB;
        for (int t = 0; t < nt; t += 2) {
            const bool last = (t == nt - 2);
            const char* a1 = cA + (size_t)(t + 1) * kstep;
            const char* a2 = last ? nA : cA + (size_t)(t + 2) * kstep; const char* b2 = last ? nB : cB + (size_t)(t + 2) * kstep;
            const char* a3 = a2 + kstep; const char* b3 = b2 + kstep;
            if (last && has_next) S.a_ready(nxt);
            if constexpr (SP2) {
            PG8_LDB(B0, 0, 0); PG8_LDB(B1, 0, 1); PG8_SCHED; PG8_LDA(At, 0, 0); PG8_STAGE(PG8_SA(1, 1), a1 + hstep, voffA);
            PG8_WAIT_V(8); PG8_WAIT_L(0); PG8_BAR; PG8_MMA(0, 0, At, B0); PG8_MMA(0, 1, At, B1); PG8_BAR; PG8_SCHED;
            PG8_LDA(At, 0, 1); PG8_STAGE(PG8_SB(0, 0), b2, voffB); PG8_STAGE(PG8_SB(0, 1), b2 + hstep, voffB); PG8_STAGE(PG8_SA(0, 0), a2, voffA);
            PG8_WAIT_V(8); PG8_WAIT_L(0); PG8_BAR; PG8_MMA(1, 0, At, B0); PG8_MMA(1, 1, At, B1); PG8_BAR; PG8_SCHED;
            PG8_LDB(B0, 1, 0); PG8_LDB(B1, 1, 1); PG8_SCHED; PG8_LDA(At, 1, 0); PG8_STAGE(PG8_SA(0, 1), a2 + hstep, voffA);
            PG8_WAIT_V(8); PG8_WAIT_L(0); PG8_BAR; PG8_MMA(0, 0, At, B0); PG8_MMA(0, 1, At, B1); PG8_BAR; PG8_SCHED;
            PG8_LDA(At, 1, 1); PG8_STAGE(PG8_SB(1, 0), b3, voffB); PG8_STAGE(PG8_SB(1, 1), b3 + hstep, voffB); PG8_STAGE(PG8_SA(1, 0), a3, voffA);
            PG8_WAIT_V(8); PG8_WAIT_L(0); PG8_BAR; PG8_MMA(1, 0, At, B0); PG8_MMA(1, 1, At, B1); PG8_BAR; PG8_SCHED;
            } else {
            PG8_LDB(B0, 0, 0); PG8_SCHED; PG8_LDA(At, 0, 0); PG8_STAGE(PG8_SA(1, 1), a1 + hstep, voffA);
            PG8_WAIT_L(8); PG8_BAR; PG8_WAIT_L(0); PG8_MMA(0, 0, At, B0); PG8_BAR; PG8_SCHED;
            PG8_LDB(B1, 0, 1); PG8_STAGE(PG8_SB(0, 0), b2, voffB);
            PG8_BAR; PG8_WAIT_L(0); PG8_MMA(0, 1, At, B1); PG8_BAR;
            PG8_LDA(At, 0, 1); PG8_STAGE(PG8_SA(0, 0), a2, voffA);
            PG8_BAR; PG8_WAIT_L(0); PG8_MMA(1, 0, At, B0); PG8_BAR; PG8_SCHED;
            PG8_STAGE(PG8_SB(0, 1), b2 + hstep, voffB);
            PG8_WAIT_V(6); PG8_BAR; PG8_MMA(1, 1, At, B1); PG8_BAR;
            PG8_LDB(B0, 1, 0); PG8_SCHED; PG8_LDA(At, 1, 0); PG8_STAGE(PG8_SA(0, 1), a2 + hstep, voffA);
            PG8_WAIT_L(8); PG8_BAR; PG8_WAIT_L(0); PG8_MMA(0, 0, At, B0); PG8_BAR; PG8_SCHED;
            PG8_LDB(B1, 1, 1); PG8_STAGE(PG8_SB(1, 0), b3, voffB);
            PG8_BAR; PG8_WAIT_L(0); PG8_MMA(0, 1, At, B1); PG8_BAR;
            PG8_LDA(At, 1, 1); PG8_STAGE(PG8_SA(1, 0), a3, voffA);
            PG8_BAR; PG8_WAIT_L(0); PG8_MMA(1, 0, At, B0); PG8_BAR; PG8_SCHED;
            PG8_STAGE(PG8_SB(1, 1), b3 + hstep, voffB);
            PG8_WAIT_V(6); PG8_BAR; PG8_MMA(1, 1, At, B1); PG8_BAR;
            }
        }
        if constexpr (ALIGN_EPI) { if (wr == 0) PG8_BAR; }
        if constexpr (!Epi::AFTER_DRAIN) { E(acc, cur, wr, wc, fr, fq); S.done(cur); }
        if (!has_next) break;
#pragma unroll
        for (int a = 0; a < 2; ++a)
#pragma unroll
            for (int b = 0; b < 2; ++b)
#pragma unroll
                for (int m = 0; m < 4; ++m)
#pragma unroll
                    for (int n = 0; n < 2; ++n) acc[a][b][m][n] = (f32x4){0.f, 0.f, 0.f, 0.f};
        cur = nxt; cA = nA; cB = nB; ++ui;
        if constexpr (ALIGN_EPI) { if (wr == 1) PG8_BAR; }
    }
    PG8_WAIT_V(0);
    if constexpr (!ALIGN_EPI) { if (wr == 0) PG8_BAR; }
    PG8_BAR;
    if constexpr (Epi::AFTER_DRAIN) { E.fused(acc, cur, wr, wc, fr, fq, lds, wid, lane); S.done(cur); }
#undef PG8_SA
#undef PG8_SB
#undef PG8_STAGE
#undef PG8_LDA
#undef PG8_LDB
#undef PG8_MMA
#undef PG8_WAIT_V
#undef PG8_WAIT_L
#undef PG8_BAR
#undef PG8_SCHED
}
}
namespace att {
#define LAS __attribute__((address_space(3)))
typedef unsigned short bf16_t;
typedef short bf16x8 __attribute__((ext_vector_type(8)));
typedef float f32x4 __attribute__((ext_vector_type(4)));
typedef float f32x16 __attribute__((ext_vector_type(16)));
typedef unsigned u32x4 __attribute__((ext_vector_type(4)));
typedef unsigned u32x2 __attribute__((ext_vector_type(2)));
typedef float f32x2 __attribute__((ext_vector_type(2)));
using pg8::cvtpk;
constexpr float LOG2E = 1.4426950408889634f;
constexpr float QK_C = 0.125f * LOG2E;
constexpr float MASKED = -3.0e38f, M_INIT = -1.0e30f;
constexpr int DA_KROW = 272, DA_VROW = 128, DA_V_OFF = 64 * DA_KROW, DA_BUF = DA_V_OFF + 128 * DA_VROW, DA_TBL_OFF = 3 * DA_BUF;
constexpr int DA_DL_OFF = DA_TBL_OFF + 3072, DA_DR_OFF = DA_DL_OFF + 2816;
constexpr int NA_SLOT = 64 * 128, NA_TBL_OFF = 11 * NA_SLOT;
static_assert(DA_DR_OFF + 641 * 4 <= 131072 && DA_V_OFF % 128 == 0 && DA_BUF % 128 == 0 && DA_TBL_OFF + 257 * 4 <= 131072 && NA_TBL_OFF + 512 * 4 <= 131072, "attention LDS");

__device__ __forceinline__ int crow(int r, int hi) { return (r & 3) + 8 * (r >> 2) + 4 * hi; }
__device__ __forceinline__ float ex2(float x) { return __builtin_amdgcn_exp2f(x); }
__device__ __forceinline__ float silu(float g) { return g * __builtin_amdgcn_rcpf(1.0f + __builtin_amdgcn_exp2f(g * -1.4426950408889634f)); }
__device__ __forceinline__ f32x16 mfma32(bf16x8 a, bf16x8 b, f32x16 c) { return __builtin_amdgcn_mfma_f32_32x32x16_bf16(a, b, c, 0, 0, 0); }
__device__ __forceinline__ int clampi(int v, int lo, int hi) { return v < lo ? lo : (v > hi ? hi : v); }

__device__ __forceinline__ float xh_max(float v) { auto rr = __builtin_amdgcn_permlane32_swap(__float_as_uint(v), __float_as_uint(v), false, false); return fmaxf(__uint_as_float(rr[0]), __uint_as_float(rr[1])); }
__device__ __forceinline__ float xh_sum(float v) { auto rr = __builtin_amdgcn_permlane32_swap(__float_as_uint(v), __float_as_uint(v), false, false); return __uint_as_float(rr[0]) + __uint_as_float(rr[1]); }
__device__ __forceinline__ float rowmax16(const f32x16& z) {
    float a = fmaxf(fmaxf(z[0], z[1]), z[2]), b = fmaxf(fmaxf(z[3], z[4]), z[5]);
    a = fmaxf(fmaxf(a, z[6]), z[7]); b = fmaxf(fmaxf(b, z[8]), z[9]); a = fmaxf(fmaxf(a, z[10]), z[11]); b = fmaxf(fmaxf(b, z[12]), z[13]); a = fmaxf(fmaxf(a, z[14]), z[15]);
    return fmaxf(a, b);
}
template <int NT> __device__ __forceinline__ void softmax_step(f32x16& z, float& m, float& l, f32x16 (&o)[NT], u32x4& p0, u32x4& p1) {
    float e[16], su = 0.f;
#pragma unroll
    for (int r = 0; r < 16; ++r) { e[r] = ex2(z[r] - m); su += e[r]; }
    if (__builtin_amdgcn_ballot_w64(!(su < 1048576.0f)) != 0ull) {
        float zm = fmaxf(fmaxf(z[0], z[1]), fmaxf(z[2], z[3]));
#pragma unroll
        for (int r = 4; r < 16; r += 4) zm = fmaxf(zm, fmaxf(fmaxf(z[r], z[r + 1]), fmaxf(z[r + 2], z[r + 3])));
        zm = xh_max(zm);
        const bool need = zm > m + 8.0f;
        const float mn = need ? zm : m;
        const float f = ex2(m - mn);
        l *= f;
#pragma unroll
        for (int t = 0; t < NT; ++t)
#pragma unroll
            for (int r = 0; r < 16; ++r) o[t][r] *= f;
        m = mn;
        su = 0.f;
#pragma unroll
        for (int r = 0; r < 16; ++r) { e[r] = ex2(z[r] - m); su += e[r]; }
    }
    l += su;
    p0.x = cvtpk(e[0], e[1]); p0.y = cvtpk(e[2], e[3]); p0.z = cvtpk(e[4], e[5]); p0.w = cvtpk(e[6], e[7]);
    p1.x = cvtpk(e[8], e[9]); p1.y = cvtpk(e[10], e[11]); p1.z = cvtpk(e[12], e[13]); p1.w = cvtpk(e[14], e[15]);
}
__device__ __forceinline__ void tr_store(LAS unsigned char* p, const u32x4 a, const u32x4 b) {
#pragma unroll
    for (int i = 0; i < 4; ++i) {
        *(LAS unsigned*)(p + (2 * i) * 144) = (a[i] & 0xffffu) | (b[i] << 16);
        *(LAS unsigned*)(p + (2 * i + 1) * 144) = (a[i] >> 16) | (b[i] & 0xffff0000u);
    }
}
__device__ __forceinline__ int vpos_of(int c) { const int c16 = c & 15; return (c & ~15) + 8 * ((c16 >> 2) & 1) + (c16 & 3) + 4 * (c16 >> 3); }

__device__ __forceinline__ int vsw(int d) { return ((d >> 3) & 1) | (((d >> 4) & 1) << 1) | ((((d >> 1) ^ (d >> 5)) & 1) << 2); }
__device__ __forceinline__ void da_unit(LAS unsigned char* lds, const bf16_t* __restrict__ proj, bf16_t* __restrict__ y, int unit,
                                        const float* __restrict__ t5, float lam, float one_m_li, const float* __restrict__ subg) {
    int tid = threadIdx.x; asm volatile("" : "+v"(tid));
    const int lane = tid & 63, wid = __builtin_amdgcn_readfirstlane(tid >> 6), l31 = lane & 31, hh = lane >> 5;
    const int qg = wid >> 1, mp = wid & 1;
    const int bh = unit >> 5, qb = unit & 31, b = bh >> 2, h = bh & 3;
    const size_t rowbase = (size_t)b * 4096;
    const int qblk = qb * 128, q0 = qblk + qg * 32, q = q0 + l31;
    LAS float* tbl = (LAS float*)(lds + DA_TBL_OFF);
    __syncthreads();
    if (tid < 257) { const int rel = tid - 128, a = rel < 0 ? -rel : rel; int large = 8 + (31 - __builtin_clz((unsigned)(a * a) | 1u)) - 6; large = large > 15 ? 15 : large;
        const int bucket = (rel > 0 ? 16 : 0) + (a < 8 ? a : large); tbl[tid] = t5[bucket * 4 + h] * LOG2E; }
    LAS float* sgt = (LAS float*)(lds + DA_TBL_OFF + 2048);
    if (tid >= 384) sgt[tid - 384] = subg[tid - 384];
    { const float bl_ = t5[15 * 4 + h], br_ = t5[31 * 4 + h];
#pragma unroll
      for (int k_ = 0; k_ < 3; ++k_) { const int e_ = tid + 512 * k_;
          if (e_ < 2 * 641) { const int side = e_ >= 641 ? 1 : 0, rel0 = e_ - 641 * side - 320, rel = clampi(rel0, -128, 128), a = rel < 0 ? -rel : rel;
              int large = 8 + (31 - __builtin_clz((unsigned)(a * a) | 1u)) - 6; large = large > 15 ? 15 : large;
              const int bucket = (rel > 0 ? 16 : 0) + (a < 8 ? a : large);
              ((LAS float*)(lds + DA_DL_OFF))[e_ + (side ? (DA_DR_OFF - DA_DL_OFF) / 4 - 641 : 0)] = (t5[bucket * 4 + h] - (side ? br_ : bl_)) * (LOG2E / QK_C); } } }
    float tbmax = t5[l31 * 4 + h] * LOG2E;
#pragma unroll
    for (int o_ = 1; o_ < 32; o_ <<= 1) tbmax = fmaxf(tbmax, __shfl_xor(tbmax, o_));
    const bf16_t* qp = proj + (rowbase + q) * 4096 + 2048 + h * 128 + mp * 64 + hh * 8;
    bf16x8 qf[4];
#pragma unroll
    for (int ks = 0; ks < 4; ++ks) qf[ks] = *(const bf16x8*)(qp + ks * 16);
    const int kc = tid & 15, kr = tid >> 4;
    const bf16_t* kvbase = proj + rowbase * 4096 + 2560 + h * 128;
    const unsigned kgo = (unsigned)(kr * 4096 + kc * 8), vgo = (unsigned)(2 * kr * 4096 + 512 + kc * 8);
    const int vps = vpos_of(2 * kr), vch = vps >> 3, vswc = vsw(8 * kc);
    const unsigned kw = kr * DA_KROW + kc * 16, vwb = DA_V_OFF + (8 * kc) * DA_VROW + ((vps & 7) >> 1) * 4;
    const unsigned vwA = vwb + ((vch ^ vswc) << 4), vwB = vwb + ((vch ^ vswc ^ 4) << 4);
    const unsigned vrd = (unsigned)(DA_V_OFF + l31 * DA_VROW) ^ (unsigned)((hh ^ vsw(l31)) << 4);
    u32x4 kreg0, kreg1, vreg0, vreg1;
#define DA_LOAD(j) do { const bf16_t* t_ = kvbase + (size_t)(j) * 64 * 4096; kreg0 = *(const u32x4*)(t_ + kgo); kreg1 = *(const u32x4*)(t_ + (kgo + 32u * 4096u)); vreg0 = *(const u32x4*)(t_ + vgo); vreg1 = *(const u32x4*)(t_ + (vgo + 4096u)); } while (0)
#define DA_STORE(B_) do { *(LAS u32x4*)((B_) + kw) = kreg0; *(LAS u32x4*)((B_) + kw + 32 * DA_KROW) = kreg1; \
        _Pragma("unroll") for (int i_ = 0; i_ < 4; ++i_) { LAS unsigned char* p_ = (B_) + ((i_ & 1) ? vwB : vwA) + (2 * i_) * DA_VROW; \
            *(LAS unsigned*)(p_) = __builtin_amdgcn_perm(vreg1[i_], vreg0[i_], 0x05040100u); *(LAS unsigned*)(p_ + DA_VROW) = __builtin_amdgcn_perm(vreg1[i_], vreg0[i_], 0x07060302u); } } while (0)
#define DA_KLD(KF_, Bk, sub) do { const LAS unsigned char* kp_ = (Bk) + (32 * (sub) + l31) * DA_KROW + mp * 128 + hh * 16; \
        _Pragma("unroll") for (int ks = 0; ks < 4; ++ks) KF_[ks] = *(const LAS bf16x8*)(kp_ + ks * 32); } while (0)
#define DA_VLD(VF_, Bv, sub, s2_) do { const unsigned r_ = (unsigned)(uintptr_t)(Bv) + vrd; \
        _Pragma("unroll") for (int dt = 0; dt < 4; ++dt) VF_[dt] = *(const LAS bf16x8*)(uintptr_t)((r_ ^ (unsigned)((4 * (sub) + 2 * (s2_)) ^ ((dt & 1) << 2)) << 4) + dt * 32 * DA_VROW); } while (0)
#define DA_QKM(S_, KF_) do { { f32x16 z_; _Pragma("unroll") for (int r_ = 0; r_ < 16; ++r_) z_[r_] = 0.f; S_ = mfma32(KF_[0], qf[0], z_); } _Pragma("unroll") for (int ks = 1; ks < 4; ++ks) S_ = mfma32(KF_[ks], qf[ks], S_); } while (0)
#define DA_PVM(VF_, P_) do { _Pragma("unroll") for (int dt = 0; dt < 4; ++dt) o[dt] = mfma32(VF_[dt], __builtin_bit_cast(bf16x8, P_), o[dt]); } while (0)
#define SB0() __builtin_amdgcn_sched_barrier(0)
#define DA_RESC(sm_, bc_) do { const float zm_ = (sm_) * QK_C + (bc_); const bool need_ = zm_ > m + 8.0f; \
        if (__builtin_amdgcn_ballot_w64(need_) != 0ull) { const float mn_ = need_ ? zm_ : m; const float f_ = ex2(m - mn_); l *= f_; \
            _Pragma("unroll") for (int t_ = 0; t_ < 4; ++t_) _Pragma("unroll") for (int r_ = 0; r_ < 16; ++r_) o[t_][r_] *= f_; \
            m = mn_; } } while (0)
#define DA_EXPO(S_, bc_, P0_, P1_, su_) do { const float c_ = (bc_) - m; float e_[16]; \
        _Pragma("unroll") for (int r_ = 0; r_ < 16; ++r_) e_[r_] = ex2(S_[r_] * QK_C + c_); \
        su_ = 0.f; _Pragma("unroll") for (int r_ = 0; r_ < 16; ++r_) su_ += e_[r_]; \
        P0_.x = cvtpk(e_[0], e_[1]); P0_.y = cvtpk(e_[2], e_[3]); P0_.z = cvtpk(e_[4], e_[5]); P0_.w = cvtpk(e_[6], e_[7]); \
        P1_.x = cvtpk(e_[8], e_[9]); P1_.y = cvtpk(e_[10], e_[11]); P1_.z = cvtpk(e_[12], e_[13]); P1_.w = cvtpk(e_[14], e_[15]); } while (0)
    f32x16 o[4];
#pragma unroll
    for (int t = 0; t < 4; ++t)
#pragma unroll
        for (int r = 0; r < 16; ++r) o[t][r] = 0.f;
    float m = M_INIT, l = 0.f;
    {
      const u32x4 a0 = *(const u32x4*)(kvbase + kgo), a1 = *(const u32x4*)(kvbase + (kgo + 32u * 4096u)), a2 = *(const u32x4*)(kvbase + vgo), a3 = *(const u32x4*)(kvbase + (vgo + 4096u));
      DA_LOAD(1);
      const u32x4 b0 = kreg0, b1 = kreg1, b2 = vreg0, b3 = vreg1;
      DA_LOAD(2);
      const u32x4 c0 = kreg0, c1 = kreg1, c2 = vreg0, c3 = vreg1;
      kreg0 = a0; kreg1 = a1; vreg0 = a2; vreg1 = a3; DA_STORE(lds);
      kreg0 = b0; kreg1 = b1; vreg0 = b2; vreg1 = b3; DA_STORE(lds + DA_BUF);
      kreg0 = c0; kreg1 = c1; vreg0 = c2; vreg1 = c3; }
    __syncthreads();
    f32x16 sa, sb;
    bf16x8 kF[4], vF[4], vS[4];
    u32x4 pp0 = {0u, 0u, 0u, 0u}, pp1 = {0u, 0u, 0u, 0u}, pc0, pc1;
    int bcur = 0, bprev = 0, bnext = DA_BUF, bnn = 2 * DA_BUF;
    bool near = (63 >= qblk - 128) && (0 <= qblk + 255); float bc = tbl[0];
    int dtoff = DA_DL_OFF;
    DA_KLD(kF, lds, 0); DA_QKM(sa, kF);
    DA_VLD(vF, lds + bprev, 1, 0);
#define DA_STEP(SC_, SN_, PP0_, PP1_, PC0_, PC1_, Bpv_, subpv_, Bqk_, subqk_, kvbc_, Bv_, subv_) do { \
        if (!((kvbc_) - (q0 + 31) >= 128 || q0 - ((kvbc_) + 31) >= 128)) {     \
            const LAS float* dp_ = (const LAS float*)(lds + dtoff) + ((kvbc_) - q + 320 + 4 * hh); \
            _Pragma("unroll") for (int r_ = 0; r_ < 16; ++r_) SC_[r_] += dp_[(r_ & 3) + 8 * (r_ >> 2)]; }     \
        DA_VLD(vS, Bpv_, subpv_, 1); SB0(); \
        DA_PVM(vF, PP0_); SB0(); \
        DA_KLD(kF, Bqk_, subqk_); SB0(); \
        DA_PVM(vS, PP1_); \
        DA_VLD(vF, Bv_, subv_, 0); SB0(); \
        DA_QKM(SN_, kF); \
        float su_; \
        DA_EXPO(SC_, bc, PC0_, PC1_, su_); \
        if (__builtin_amdgcn_ballot_w64(!(su_ < 1048576.0f)) != 0ull) {     \
            const float sm_ = xh_max(rowmax16(SC_)); \
            DA_RESC(sm_, bc); \
            DA_EXPO(SC_, bc, PC0_, PC1_, su_); } \
        l += su_; } while (0)
#pragma unroll 2
    for (int j = 0; j < 64; ++j) {
        const int j1 = j + 1;
        const bool near1 = (64 * j1 + 63 >= qblk - 128) && (64 * j1 <= qblk + 255);
        const float bc1 = tbl[(64 * j1 > qblk) ? 256 : 0]; const int dtoff1 = (64 * j1 > qblk) ? DA_DR_OFF : DA_DL_OFF;
        DA_STEP(sa, sb, pp0, pp1, pc0, pc1, lds + bprev, 1, lds + bcur, 1, j * 64, lds + bcur, 0);
        __syncthreads();
        DA_STORE(lds + bnn); { const int jl = j + 3 < 64 ? j + 3 : 63; DA_LOAD(jl); }
        DA_STEP(sb, sa, pc0, pc1, pp0, pp1, lds + bcur, 0, lds + bnext, 0, j * 64 + 32, lds + bcur, 1);
        bprev = bcur; bcur = bnext; bnext = bnn; bnn = bprev; near = near1; bc = bc1; dtoff = dtoff1;
    }
    const bf16_t* gp = proj + (rowbase + q) * 4096 + 3584 + h * 128;
    u32x2 gvv[16];
    if (mp == 0) {
#pragma unroll
        for (int i = 0; i < 16; ++i) gvv[i] = *(const u32x2*)(gp + (i >> 2) * 32 + 8 * (i & 3) + 4 * hh);
    }
    DA_VLD(vS, lds + bprev, 1, 1);
    DA_PVM(vF, pp0); DA_PVM(vS, pp1);
    __syncthreads();
#undef DA_EXPO
#undef DA_RESC
#undef DA_STEP
#undef DA_KLD
#undef DA_VLD
#undef DA_QKM
#undef DA_PVM
#undef SB0
#undef DA_LOAD
#undef DA_STORE
    l = xh_sum(l);
    const float sc = (mp == 0 ? 1.0f : lam) * __builtin_amdgcn_rcpf(l);
    LAS float* ex = (LAS float*)lds + (qg * 128) * 32 + l31;
    if (mp == 1) {
#pragma unroll
        for (int dt = 0; dt < 4; ++dt)
#pragma unroll
            for (int r = 0; r < 16; ++r) ex[(dt * 32 + crow(r, hh)) * 32] = o[dt][r] * sc;
    }
    __syncthreads();
    if (mp == 0) {
        float ss = 0.f;
#pragma unroll
        for (int dt = 0; dt < 4; ++dt)
#pragma unroll
            for (int r = 0; r < 16; ++r) { const float v = o[dt][r] * sc - ex[(dt * 32 + crow(r, hh)) * 32]; o[dt][r] = v; ss += v * v; }
        ss = xh_sum(ss);
        const float rn = one_m_li * __builtin_amdgcn_rsqf(ss * (1.0f / 128.0f) + 1e-5f);
        bf16_t* yp = y + (rowbase + q) * 1024 + 512 + h * 128;
#pragma unroll
        for (int dt = 0; dt < 4; ++dt)
#pragma unroll
            for (int g = 0; g < 4; ++g) {
                const int d = dt * 32 + 8 * g + 4 * hh;
                const u32x2 gv = gvv[dt * 4 + g]; const f32x4 sg = *(const LAS f32x4*)(sgt + d);
                const float g0 = __uint_as_float(gv.x << 16), g1 = __uint_as_float(gv.x & 0xffff0000u), g2 = __uint_as_float(gv.y << 16), g3 = __uint_as_float(gv.y & 0xffff0000u);
                u32x2 w; w.x = cvtpk(o[dt][4 * g] * rn * sg[0] * silu(g0), o[dt][4 * g + 1] * rn * sg[1] * silu(g1));
                w.y = cvtpk(o[dt][4 * g + 2] * rn * sg[2] * silu(g2), o[dt][4 * g + 3] * rn * sg[3] * silu(g3));
                *(u32x2*)(yp + d) = w;
            }
    }
}

__device__ __forceinline__ void na_unit(LAS unsigned char* lds, const bf16_t* __restrict__ proj, bf16_t* __restrict__ y, int unit, const float* __restrict__ rpb) {
    int tid = threadIdx.x; asm volatile("" : "+v"(tid));
    const int lane = tid & 63, wid = __builtin_amdgcn_readfirstlane(tid >> 6), l31 = lane & 31, hh = lane >> 5;
    const int rg = unit & 15, bh = unit >> 4, h = bh & 7, b = bh >> 3;
    const size_t rowbase = (size_t)b * 4096;
    const int r0 = rg * 4, rlo = clampi(r0 - 4, 0, 56), rhi = clampi(r0 - 1, 0, 56) + 7, nrows = rhi - rlo + 1;
    LAS float* tbl = (LAS float*)(lds + NA_TBL_OFF);
    __syncthreads();
    { const int dr = tid >> 5, ci = tid & 31; tbl[tid] = (dr < 15 && ci < 31) ? rpb[h * 465 + dr * 31 + ci] * LOG2E : MASKED; }
    { const int c8 = tid & 7, cp = (tid >> 3) & 31, par = tid >> 8;
      const int pos = vpos_of(2 * cp), ch = pos >> 3, sw0 = vsw(8 * c8);
      const unsigned wb = (8 * c8) * 128 + ((pos & 7) >> 1) * 4, wA = wb + ((ch ^ sw0) << 4), wB = wb + ((ch ^ sw0 ^ 4) << 4);
      const bf16_t* gbase = proj + (rowbase + rlo * 64 + 2 * cp) * 4096 + 1024 + h * 64 + c8 * 8;
      u32x4 va[6], vb[6];
#pragma unroll
      for (int k = 0; k < 6; ++k) { const int i = 2 * k + par, ic = i < nrows ? i : nrows - 1; const bf16_t* g = gbase + (size_t)ic * 64 * 4096; va[k] = *(const u32x4*)g; vb[k] = *(const u32x4*)(g + 4096); }
#pragma unroll
      for (int k = 0; k < 6; ++k) { const int i = 2 * k + par; if (i < nrows) { LAS unsigned char* S = lds + i * NA_SLOT;
#pragma unroll
          for (int i2 = 0; i2 < 4; ++i2) { LAS unsigned char* p = S + ((i2 & 1) ? wB : wA) + (2 * i2) * 128;
              *(LAS unsigned*)p = __builtin_amdgcn_perm(vb[k][i2], va[k][i2], 0x05040100u); *(LAS unsigned*)(p + 128) = __builtin_amdgcn_perm(vb[k][i2], va[k][i2], 0x07060302u); } } }
    }
    __syncthreads();
    const int rf = r0 + 2 * (wid >> 2), kblk = wid & 3, c0 = 16 * kblk;
    const int r = rf + (l31 >> 4), c = c0 + (l31 & 15), rs = clampi(r - 4, 0, 56), cs = clampi(c - 8, 0, 48);
    const int rst = clampi(rf - 4, 0, 56), ntile = clampi(rf - 3, 0, 56) - rst + 8;
    const bf16_t* qp = proj + (rowbase + r * 64 + c) * 4096 + h * 64 + hh * 8;
    bf16x8 qf[4];
#pragma unroll
    for (int ks = 0; ks < 4; ++ks) qf[ks] = *(const bf16x8*)(qp + ks * 16);
    unsigned cpk[4];
#pragma unroll
    for (int w = 0; w < 4; ++w) { unsigned v = 0u;
#pragma unroll
        for (int e4 = 0; e4 < 4; ++e4) { const int kcol = c0 - 8 + crow(4 * w + e4, hh); const bool valid = (kcol >= cs) && (kcol <= cs + 15);
            v |= (unsigned)(valid ? kcol - c + 15 : 31) << (8 * e4); }
        cpk[w] = v; }
    f32x16 o[2];
#pragma unroll
    for (int t = 0; t < 2; ++t)
#pragma unroll
        for (int rr = 0; rr < 16; ++rr) o[t][rr] = 0.f;
    float m = M_INIT, l = 0.f;
    const bf16_t* kbase = proj + (rowbase + rst * 64 + clampi(c0 - 8 + l31, 0, 63)) * 4096 + 512 + h * 64 + hh * 8;
#define NA_KPTR(t_) (kbase + (size_t)(t_) * 64 * 4096)
    const unsigned vrd = (unsigned)(l31 * 128) ^ (unsigned)((hh ^ vsw(l31)) << 4);
    const unsigned xa0 = (unsigned)(2 * clampi(kblk - 1, 0, 3)) << 4, xb0 = (unsigned)(2 * kblk) << 4, xa1 = xb0, xb1 = (unsigned)(2 * clampi(kblk + 1, 0, 3)) << 4;
    bf16x8 kq[4][4];
#pragma unroll
    for (int t = 0; t < 3; ++t)
#pragma unroll
        for (int ks = 0; ks < 4; ++ks) kq[t][ks] = *(const bf16x8*)(NA_KPTR(t) + ks * 16);
#pragma unroll
    for (int t = 0; t < 9; ++t) {
        if (t < 8 || ntile == 9) {
        { const int tl = (t + 3 < ntile) ? t + 3 : ntile - 1;
#pragma unroll
          for (int ks = 0; ks < 4; ++ks) kq[(t + 3) & 3][ks] = *(const bf16x8*)(NA_KPTR(tl) + ks * 16); }
        const int krow = rst + t;
        const LAS float* trow = tbl + (((krow >= rs) && (krow <= rs + 7)) ? krow - r + 7 : 15) * 32;
        const unsigned vslot = (unsigned)(uintptr_t)(lds + (krow - rlo) * NA_SLOT) + vrd;
        f32x16 s;
        { f32x16 z;
#pragma unroll
          for (int rr = 0; rr < 16; ++rr) z[rr] = 0.f;
          s = mfma32(kq[t & 3][0], qf[0], z); }
#pragma unroll
        for (int ks = 1; ks < 4; ++ks) s = mfma32(kq[t & 3][ks], qf[ks], s);
#pragma unroll
        for (int rr = 0; rr < 16; ++rr) { const unsigned ci = (cpk[rr >> 2] >> (8 * (rr & 3))) & 0xffu; s[rr] = s[rr] * QK_C + trow[ci]; }
        u32x4 p0, p1;
        softmax_step<2>(s, m, l, o, p0, p1);
#pragma unroll
        for (int dt = 0; dt < 2; ++dt) {
            const unsigned dx = (unsigned)((dt & 1) << 2) << 4, db = dt * 32 * 128;
            const u32x2 a0 = *(const LAS u32x2*)(uintptr_t)((vslot ^ xa0 ^ dx) + db + 8), b0 = *(const LAS u32x2*)(uintptr_t)((vslot ^ xb0 ^ dx) + db);
            const u32x2 a1 = *(const LAS u32x2*)(uintptr_t)((vslot ^ xa1 ^ dx) + db + 8), b1 = *(const LAS u32x2*)(uintptr_t)((vslot ^ xb1 ^ dx) + db);
            const u32x4 v0 = {a0.x, a0.y, b0.x, b0.y}, v1 = {a1.x, a1.y, b1.x, b1.y};
            o[dt] = mfma32(__builtin_bit_cast(bf16x8, v0), __builtin_bit_cast(bf16x8, p0), o[dt]);
            o[dt] = mfma32(__builtin_bit_cast(bf16x8, v1), __builtin_bit_cast(bf16x8, p1), o[dt]);
        }
        }
    }
#undef NA_KPTR
    l = xh_sum(l);
    const float il = __builtin_amdgcn_rcpf(l);
    const size_t tok = rowbase + r * 64 + c;
    const bf16_t* gp = proj + tok * 4096 + 1536 + h * 64;
    bf16_t* yp = y + tok * 1024 + h * 64;
#pragma unroll
    for (int dt = 0; dt < 2; ++dt)
#pragma unroll
        for (int g = 0; g < 4; ++g) {
            const int d = dt * 32 + 8 * g + 4 * hh;
            const u32x2 gv = *(const u32x2*)(gp + d);
            const float g0 = __uint_as_float(gv.x << 16), g1 = __uint_as_float(gv.x & 0xffff0000u), g2 = __uint_as_float(gv.y << 16), g3 = __uint_as_float(gv.y & 0xffff0000u);
            u32x2 w; w.x = cvtpk(o[dt][4 * g] * il * silu(g0), o[dt][4 * g + 1] * il * silu(g1));
            w.y = cvtpk(o[dt][4 * g + 2] * il * silu(g2), o[dt][4 * g + 3] * il * silu(g3));
            *(u32x2*)(yp + d) = w;
        }
}
}
typedef unsigned short bf16_t;
constexpr int M_TOK = 65536, DMODEL = 1024, NIN = 4096, DEPTH = 4;
constexpr size_t MiB = 1u << 20;
constexpr size_t WS_WIN = 0, WS_WOUT = 32 * MiB, WS_SSQ = 40 * MiB, WS_XB = 64 * MiB, WS_Y = 192 * MiB, WS_PROJ = 320 * MiB, WS_CTL = 832 * MiB, CTL_BYTES = 16384, WS_END = 833 * MiB;
constexpr int LDS_BYTES = 131072 + 256, MISC_OFF = 131072;
#ifndef MK_N_LAUNCHES
#define MK_N_LAUNCHES 1
#endif

__device__ __forceinline__ float wave_sum(float v) {
#pragma unroll
    for (int o = 1; o < 64; o <<= 1) v += __shfl_xor(v, o);
    return v;
}
__device__ __forceinline__ void p0_transpose_item(const float* W, int K, int N, bf16_t* WT, const float* gk, LAS float* scr, int item, int lane) {
    const int nblk = N / 32, kb = item / nblk, nb = item % nblk, k0 = 64 * kb, n0 = 32 * nb;
    float wv[32];
#pragma unroll
    for (int i = 0; i < 32; ++i) { const int kk = 2 * i + (lane >> 5); wv[i] = W[(size_t)(k0 + kk) * N + n0 + (lane & 31)]; }
#pragma unroll
    for (int i = 0; i < 32; ++i) { const int kk = 2 * i + (lane >> 5); const float g = gk ? gk[k0 + kk] : 1.0f; scr[kk * 33 + (lane & 31)] = wv[i] * g; }
    asm volatile("s_waitcnt lgkmcnt(0)" ::: "memory");
    const int c = lane & 7;
#pragma unroll
    for (int j = 0; j < 4; ++j) { const int n = (lane >> 3) + 8 * j; const LAS float* s = scr + (8 * c) * 33 + n;
        att::u32x4 o; o.x = pg8::cvtpk(s[0 * 33], s[1 * 33]); o.y = pg8::cvtpk(s[2 * 33], s[3 * 33]); o.z = pg8::cvtpk(s[4 * 33], s[5 * 33]); o.w = pg8::cvtpk(s[6 * 33], s[7 * 33]);
        *(att::u32x4*)(WT + (size_t)(n0 + n) * K + k0 + 8 * c) = o; }
    asm volatile("s_waitcnt lgkmcnt(0)" ::: "memory");
}

#define XB_TMO      128
#define XB_XCNT(j)  (256  + 64 * (j))
#define XB_XSUB(j)  (1280 + 64 * (j))
#define XB_XGEN(j)  (2304 + 64 * (j))
#define XB_TOP      3328
#define XB_TOPGEN   3392
#define XCD_BAR_WORDS 3456
#define XB_SPIN_CAP (1u << 18)

__device__ __forceinline__ unsigned xb_ld(unsigned* p)              { return __hip_atomic_load(p, __ATOMIC_RELAXED, __HIP_MEMORY_SCOPE_AGENT); }
__device__ __forceinline__ unsigned xb_add(unsigned* p, unsigned v) { return __hip_atomic_fetch_add(p, v, __ATOMIC_RELAXED, __HIP_MEMORY_SCOPE_AGENT); }
__device__ __forceinline__ unsigned xb_xcc_id() { return (unsigned)__builtin_amdgcn_s_getreg((3 << 11) | 20) & 0xFu; }
#define XB_SPIN(cond, bar) do { unsigned _sp = 0; while (cond) { __builtin_amdgcn_s_sleep(1); \
    if ((++_sp & 255u) == 0u) { if (xb_ld(&(bar)[XB_TMO])) break; if (_sp > XB_SPIN_CAP) { atomicAdd(&(bar)[XB_TMO], 1u); break; } } } } while (0)

struct XcdBarrier {
    unsigned* bar; unsigned x;
    volatile LAS unsigned* st;
};

__device__ __forceinline__ XcdBarrier xcd_barrier_post(unsigned* bar, volatile LAS unsigned* st) {
    XcdBarrier b; b.bar = bar; b.x = xb_xcc_id(); b.st = st;
    if (threadIdx.x == 0) (void)xb_add(&bar[XB_XCNT(b.x)], 1u);
    return b;
}
__device__ __forceinline__ void xcd_barrier_complete(unsigned* bar, unsigned x, unsigned& nloc, unsigned& nx) {
    const unsigned G = gridDim.x * gridDim.y * gridDim.z;
    unsigned sum, cnt, mine, sp = 0u;
    for (;;) {
        sum = 0u; cnt = 0u; mine = 0u;
#pragma unroll
        for (unsigned j = 0; j < 16; ++j) { const unsigned c = xb_ld(&bar[XB_XCNT(j)]); sum += c; cnt += (c > 0u) ? 1u : 0u; mine = (j == x) ? c : mine; }
        if (sum == G) break;
        __builtin_amdgcn_s_sleep(1);
        if ((++sp & 255u) == 0u) { if (xb_ld(&bar[XB_TMO])) break; if (sp > XB_SPIN_CAP) { atomicAdd(&bar[XB_TMO], 1u); break; } }
    }
    nloc = mine > 0u ? mine : 1u; nx = cnt > 0u ? cnt : 1u;
}

__device__ __forceinline__ void xcd_barrier(const XcdBarrier& b) {
    asm volatile("s_waitcnt vmcnt(0)" ::: "memory");
    __syncthreads();
    if (threadIdx.x == 0) {
        unsigned* bar = b.bar;
        __builtin_amdgcn_s_waitcnt(0);
        unsigned nloc = b.st[0], nx = b.st[1];
        if (nloc == 0u) { xcd_barrier_complete(bar, b.x, nloc, nx); b.st[0] = nloc; b.st[1] = nx; }
        const unsigned old = xb_add(&bar[XB_XSUB(b.x)], 1u);
        const unsigned gen = old / nloc;
        if (old + 1u == (gen + 1u) * nloc) {
            __builtin_amdgcn_fence(__ATOMIC_RELEASE, "agent");
            asm volatile("s_waitcnt vmcnt(0)" ::: "memory");
            const unsigned og = xb_add(&bar[XB_TOP], 1u);
            const unsigned tg = og / nx;
            if (og + 1u == (tg + 1u) * nx) xb_add(&bar[XB_TOPGEN], 1u);
            else XB_SPIN(xb_ld(&bar[XB_TOPGEN]) == tg, bar);
            __builtin_amdgcn_fence(__ATOMIC_ACQUIRE, "agent");
            xb_add(&bar[XB_XGEN(b.x)], 1u);
            asm volatile("s_waitcnt vmcnt(0)" ::: "memory");
        } else {
            XB_SPIN(xb_ld(&bar[XB_XGEN(b.x)]) == gen, bar);
            __builtin_amdgcn_fence(__ATOMIC_ACQUIRE, "agent");
            asm volatile("s_waitcnt vmcnt(0)" ::: "memory");
        }
    }
    __syncthreads();
}

struct Args { const float* x; const float* norm_g; const float* w_in; const float* rpb; const float* lq1; const float* lk1; const float* lq2; const float* lk2;
              const float* subg; const float* t5; const float* w_out; const float* final_g; float* out; unsigned char* ws; long long ph_lo, ph_hi; };

constexpr int N_PHASES = 14;
__global__ void __launch_bounds__(512, 2) fwd_megakernel(Args a) {
    extern __shared__ __attribute__((aligned(16))) unsigned char lds_raw[];
    LAS unsigned char* lds = (LAS unsigned char*)lds_raw;
    const int G = gridDim.x, bx = blockIdx.x, vcu = (G % 8 == 0) ? (bx % 8) * (G / 8) + bx / 8 : bx;
    const int NGW = G * 8;
    unsigned char* ws = a.ws;
    bf16_t* WinT = (bf16_t*)(ws + WS_WIN); bf16_t* WoutT = (bf16_t*)(ws + WS_WOUT); float* ssq = (float*)(ws + WS_SSQ);
    bf16_t* xb = (bf16_t*)(ws + WS_XB); bf16_t* yb = (bf16_t*)(ws + WS_Y); bf16_t* proj = (bf16_t*)(ws + WS_PROJ);
    const int lo = (int)a.ph_lo, hi = (int)a.ph_hi;
#define IN(k) (lo <= (k) && (k) < hi)
    { int t_ = threadIdx.x; if (t_ < 64) ((volatile LAS unsigned*)(lds + MISC_OFF))[t_] = 0u; __syncthreads(); }
    const XcdBarrier xbar = xcd_barrier_post((unsigned*)(ws + WS_CTL), (volatile LAS unsigned*)(lds + MISC_OFF) + 8);
#define SEAM(k) do { if (IN(k) && IN((k) + 1)) { if ((k) == 0) cg::this_grid().sync(); else xcd_barrier(xbar); } } while (0)

    if (IN(0)) {
        int t0 = threadIdx.x; asm volatile("" : "+v"(t0)); const int lane = t0 & 63, wid = __builtin_amdgcn_readfirstlane(t0 >> 6), gw = bx * 8 + wid;
        LAS float* scr = (LAS float*)(lds + wid * 16384);
        constexpr int I_IN = (DMODEL / 64) * (NIN / 32), I_OUT = (DMODEL / 64) * (DMODEL / 32), I_L = I_IN + I_OUT;
        for (int it = gw; it < DEPTH * I_L; it += NGW) {
            const int l = it / I_L, r = it % I_L;
            if (r < I_IN) p0_transpose_item(a.w_in + (size_t)l * DMODEL * NIN, DMODEL, NIN, WinT + (size_t)l * NIN * DMODEL, a.norm_g + l * DMODEL, scr, r, lane);
            else p0_transpose_item(a.w_out + (size_t)l * DMODEL * DMODEL, DMODEL, DMODEL, WoutT + (size_t)l * DMODEL * DMODEL, nullptr, scr, r - I_IN, lane);
        }
        for (int m = gw; m < M_TOK; m += 2 * NGW) {
            const int mb = (m + NGW < M_TOK) ? m + NGW : m;
            const att::f32x4* xr = (const att::f32x4*)(a.x + (size_t)m * DMODEL) + lane; const att::f32x4* xq = (const att::f32x4*)(a.x + (size_t)mb * DMODEL) + lane;
            att::f32x4 v[4], w4[4]; float s = 0.f, s2 = 0.f;
#pragma unroll
            for (int j = 0; j < 4; ++j) { v[j] = __builtin_nontemporal_load(xr + 64 * j); w4[j] = __builtin_nontemporal_load(xq + 64 * j); }
#pragma unroll
            for (int j = 0; j < 4; ++j) { s += (v[j][0] * v[j][0] + v[j][1] * v[j][1]) + (v[j][2] * v[j][2] + v[j][3] * v[j][3]); s2 += (w4[j][0] * w4[j][0] + w4[j][1] * w4[j][1]) + (w4[j][2] * w4[j][2] + w4[j][3] * w4[j][3]); }
            s = wave_sum(s); s2 = wave_sum(s2);
            att::u32x2* o8 = (att::u32x2*)(xb + (size_t)m * DMODEL) + lane; att::u32x2* o9 = (att::u32x2*)(xb + (size_t)mb * DMODEL) + lane;
#pragma unroll
            for (int j = 0; j < 4; ++j) { att::u32x2 w; w.x = pg8::cvtpk(v[j][0], v[j][1]); w.y = pg8::cvtpk(v[j][2], v[j][3]); o8[64 * j] = w;
                                          att::u32x2 y; y.x = pg8::cvtpk(w4[j][0], w4[j][1]); y.y = pg8::cvtpk(w4[j][2], w4[j][3]); o9[64 * j] = y; }
            if (lane < 16) { ssq[(size_t)m * 16 + lane] = (lane == 0) ? s : 0.f; ssq[(size_t)mb * 16 + lane] = (lane == 0) ? s2 : 0.f; }
        }
    }
    SEAM(0);
    for (int l = 0; l < DEPTH; ++l) {
        if (IN(1 + 3 * l)) {
            pg8::Gemm g{xb, WinT + (size_t)l * NIN * DMODEL, M_TOK, NIN, DMODEL}; pg8::StaticOrder S; S.init(M_TOK, NIN, G, bx);
            pg8::EpiProj E{proj, ssq, NIN};
            pg8::gemm_phase<pg8::EpiProj, pg8::StaticOrder, true, true>(lds, g, S, E);
        }
        SEAM(1 + 3 * l);
        if (IN(2 + 3 * l)) {
            int lz = l, lanez = threadIdx.x; asm volatile("" : "+s"(lz), "+v"(lanez)); lanez &= 63;
            const float li = 0.8f - 0.6f * expf(-0.3f * (float)lz);
            const float p1 = wave_sum(a.lq1[lz * 64 + lanez] * a.lk1[lz * 64 + lanez]), p2 = wave_sum(a.lq2[lz * 64 + lanez] * a.lk2[lz * 64 + lanez]);
            const float lam = __uint_as_float(__builtin_amdgcn_readfirstlane(__float_as_uint(expf(p1) - expf(p2) + li)));
            const int vcuz = vcu + (lz - l);
            for (int u = vcuz; u < 2048; u += G) att::da_unit(lds, proj, yb, u, a.t5, lam, __uint_as_float(__builtin_amdgcn_readfirstlane(__float_as_uint(1.0f - li))), a.subg + lz * 128);
            for (int u = vcuz; u < 2048; u += G) att::na_unit(lds, proj, yb, u, a.rpb + (size_t)lz * 8 * 465);
            __syncthreads();
        }
        SEAM(2 + 3 * l);
        if (IN(3 + 3 * l)) {
            pg8::Gemm g{yb, WoutT + (size_t)l * DMODEL * DMODEL, M_TOK, DMODEL, DMODEL}; pg8::StaticOrder S; S.init(M_TOK, DMODEL, G, bx);
            pg8::EpiOut E{xb, ssq};
            pg8::gemm_phase<pg8::EpiOut, pg8::StaticOrder, true, true>(lds, g, S, E);
        }
        SEAM(3 + 3 * l);
    }
    if (IN(13)) {
        int t13 = threadIdx.x; asm volatile("" : "+v"(t13)); const int lane = t13 & 63, gw = bx * 8 + (t13 >> 6);
        att::f32x4 fg[4];
#pragma unroll
        for (int j = 0; j < 4; ++j) fg[j] = *((const att::f32x4*)a.final_g + lane + 64 * j);
        for (int m = gw; m < M_TOK; m += 2 * NGW) {
            const int mb = (m + NGW < M_TOK) ? m + NGW : m;
            const att::u32x2* xr = (const att::u32x2*)(xb + (size_t)m * DMODEL) + lane; const att::u32x2* xq = (const att::u32x2*)(xb + (size_t)mb * DMODEL) + lane;
            att::u32x2 ra[4], rb[4];
#pragma unroll
            for (int j = 0; j < 4; ++j) { ra[j] = xr[64 * j]; rb[j] = xq[64 * j]; }
            att::f32x4 v[4], w4[4]; float s = 0.f, s2 = 0.f;
#pragma unroll
            for (int j = 0; j < 4; ++j) {
                v[j][0] = __uint_as_float(ra[j].x << 16); v[j][1] = __uint_as_float(ra[j].x & 0xffff0000u); v[j][2] = __uint_as_float(ra[j].y << 16); v[j][3] = __uint_as_float(ra[j].y & 0xffff0000u);
                w4[j][0] = __uint_as_float(rb[j].x << 16); w4[j][1] = __uint_as_float(rb[j].x & 0xffff0000u); w4[j][2] = __uint_as_float(rb[j].y << 16); w4[j][3] = __uint_as_float(rb[j].y & 0xffff0000u);
                s += (v[j][0] * v[j][0] + v[j][1] * v[j][1]) + (v[j][2] * v[j][2] + v[j][3] * v[j][3]); s2 += (w4[j][0] * w4[j][0] + w4[j][1] * w4[j][1]) + (w4[j][2] * w4[j][2] + w4[j][3] * w4[j][3]); }
            s = wave_sum(s); s2 = wave_sum(s2);
            const float rs = 1.0f / sqrtf(s * (1.0f / 1024.0f) + 1e-6f), rs2 = 1.0f / sqrtf(s2 * (1.0f / 1024.0f) + 1e-6f);
            att::f32x4* orow = (att::f32x4*)(a.out + (size_t)m * DMODEL) + lane; att::f32x4* orow2 = (att::f32x4*)(a.out + (size_t)mb * DMODEL) + lane;
#pragma unroll
            for (int j = 0; j < 4; ++j) { __builtin_nontemporal_store(v[j] * rs * fg[j], orow + 64 * j); __builtin_nontemporal_store(w4[j] * rs2 * fg[j], orow2 + 64 * j); }
        }
    }
#undef IN
#undef SEAM
}

extern "C" void kernel_launch(void* const* d_in, const int* in_sizes, int n_in, void* d_out, int out_size, void* d_ws, size_t ws_size, hipStream_t stream) {
    static int grid = 0;
    if (grid == 0) {
        if (n_in != 12 || in_sizes[0] != M_TOK * DMODEL || out_size != M_TOK * DMODEL || ws_size < WS_END) { fprintf(stderr, "kernel_launch: unexpected shapes (n_in %d, ws %zu)\n", n_in, ws_size); grid = -1; return; }
        int dev = 0, cus = 0, per_cu = 0;
        hipGetDevice(&dev); hipDeviceGetAttribute(&cus, hipDeviceAttributeMultiprocessorCount, dev);
        if (hipFuncSetAttribute((const void*)fwd_megakernel, hipFuncAttributeMaxDynamicSharedMemorySize, LDS_BYTES) != hipSuccess) { fprintf(stderr, "kernel_launch: hipFuncSetAttribute failed\n"); grid = -1; return; }
        if (hipOccupancyMaxActiveBlocksPerMultiprocessor(&per_cu, (const void*)fwd_megakernel, 512, LDS_BYTES) != hipSuccess || per_cu < 1) { fprintf(stderr, "kernel_launch: occupancy query says %d\n", per_cu); per_cu = 1; }
        (void)hipGetLastError();
        grid = cus * 1;
    }
    if (grid < 0) return;
    if (hipMemsetAsync((char*)d_ws + WS_CTL, 0, CTL_BYTES, stream) != hipSuccess) { fprintf(stderr, "kernel_launch: hipMemsetAsync failed\n"); return; }
    Args a{};
    a.x = (const float*)d_in[0]; a.norm_g = (const float*)d_in[1]; a.w_in = (const float*)d_in[2]; a.rpb = (const float*)d_in[3];
    a.lq1 = (const float*)d_in[4]; a.lk1 = (const float*)d_in[5]; a.lq2 = (const float*)d_in[6]; a.lk2 = (const float*)d_in[7];
    a.subg = (const float*)d_in[8]; a.t5 = (const float*)d_in[9]; a.w_out = (const float*)d_in[10]; a.final_g = (const float*)d_in[11];
    a.out = (float*)d_out; a.ws = (unsigned char*)d_ws;
#if MK_N_LAUNCHES == 1
    a.ph_lo = 0; a.ph_hi = N_PHASES;
    void* args[] = {&a};
    const hipError_t e = hipLaunchCooperativeKernel((const void*)fwd_megakernel, dim3(grid), dim3(512), args, LDS_BYTES, stream);
    if (e != hipSuccess) fprintf(stderr, "kernel_launch: cooperative launch failed: %s (grid %d)\n", hipGetErrorString(e), grid);
#else
    for (int p = 0; p < N_PHASES; ++p) { a.ph_lo = p; a.ph_hi = p + 1; hipLaunchKernelGGL(fwd_megakernel, dim3(grid), dim3(512), LDS_BYTES, stream, a); }
#endif
}
```

```cpp
#include <hip/hip_runtime.h>
#include <hip/hip_cooperative_groups.h>
#include <cstdio>
#include <cstdint>
namespace cg = cooperative_groups;
namespace pg8 {
#define PG8_LAS __attribute__((address_space(3)))
typedef unsigned short bf16_t;
typedef short bf16x8 __attribute__((ext_vector_type(8)));
typedef float f32x4 __attribute__((ext_vector_type(4)));
typedef unsigned u32x4 __attribute__((ext_vector_type(4)));
constexpr int BM = 256, BK = 64, HALF = 128, HTB = HALF * BK * 2  , STAGE_BYTES = 8 * HTB, NXCD = 8, WGM = 8;

__host__ __device__ __forceinline__ int lds_byte(int r, int c) { const int st = (r >> 4) * 2 + (c >> 5), rr = r & 15, cc = c & 31, ob = rr * 64 + cc * 2; return st * 1024 + (ob ^ (((ob >> 9) & 1) << 5)); }
__host__ __device__ __forceinline__ void stage_rc(int b, int& R, int& C) { const int st = b / 1024, sb = b % 1024, swz = sb ^ (((sb >> 9) & 1) << 5); R = (st >> 1) * 16 + swz / 64; C = (st & 1) * 32 + (swz % 64) / 2; }
__host__ __device__ __forceinline__ int perm32(int rho) { const int n = rho >> 4, i = rho & 15; return 8 * (i >> 2) + 4 * n + (i & 3); }

struct Unit { int pm, pn; };
struct Gemm { const bf16_t* A; const bf16_t* Bt; int M, N, K; };

struct StaticOrder {
    int nM, nN, nwg, G, c;
    __host__ __device__ void init(int M, int N, int G_, int c_) { nM = M / BM; nN = N / BM; nwg = nM * nN; G = G_; c = c_; }
    __host__ __device__ bool next(int i, Unit& u) const {
        const long L = (long)i * G + c; if (L >= nwg) return false;
        int wgid = (int)L; { const int q = nwg / NXCD, r = nwg % NXCD, xcd = wgid % NXCD, off = wgid / NXCD; wgid = (xcd < r ? xcd * (q + 1) : r * (q + 1) + (xcd - r) * q) + off; }
        const int nig = WGM * nN, gid = wgid / nig, fm = gid * WGM, gsz = (nM - fm) < WGM ? (nM - fm) : WGM;
        u.pm = fm + ((wgid % nig) % gsz); u.pn = (wgid % nig) / gsz; return true;
    }
    __device__ __forceinline__ void a_ready(const Unit&) const {}
    __device__ __forceinline__ void done(const Unit&) const {}
};

typedef float f32x2_t __attribute__((ext_vector_type(2))); typedef __bf16 bf16x2_t __attribute__((ext_vector_type(2)));
__device__ __forceinline__ unsigned cvtpk(float lo, float hi) { f32x2_t v = {lo, hi}; bf16x2_t b = __builtin_convertvector(v, bf16x2_t); return __builtin_bit_cast(unsigned, b); }
typedef unsigned u32x2 __attribute__((ext_vector_type(2)));
__device__ __forceinline__ float sum_rows4(float v) {
    auto a = __builtin_amdgcn_permlane16_swap(__float_as_uint(v), __float_as_uint(v), false, false); const float s = __uint_as_float(a[0]) + __uint_as_float(a[1]);
    auto b = __builtin_amdgcn_permlane32_swap(__float_as_uint(s), __float_as_uint(s), false, false); return __uint_as_float(b[0]) + __uint_as_float(b[1]);
}

struct EpiProj {
    static constexpr bool PERM = true, AFTER_DRAIN = false;
    bf16_t* O; const float* ssq; int ldc;
    __device__ __forceinline__ void operator()(const f32x4 (&acc)[2][2][4][2], const Unit& u, int wr, int wc, int fr, int fq) const {
        const int row0 = u.pm * BM + wr * 64 + fr; const int col0 = u.pn * BM + wc * 32 + 8 * fq;
#pragma unroll
        for (int ai = 0; ai < 2; ++ai)
#pragma unroll
            for (int m = 0; m < 4; ++m) {
                const int row = row0 + ai * HALF + m * 16;
                const f32x4 a = *((const f32x4*)(ssq + (size_t)row * 16) + fq);
                float tot = (a[0] + a[1]) + (a[2] + a[3]);
                tot = sum_rows4(tot);
                const float rs = __builtin_amdgcn_rsqf(tot * (1.0f / 1024.0f) + 1e-6f);
                bf16_t* rowp = O + (size_t)row * ldc + col0;
#pragma unroll
                for (int bj = 0; bj < 2; ++bj) { const f32x4 v0 = acc[ai][bj][m][0] * rs, v1 = acc[ai][bj][m][1] * rs;
                    u32x4 w; w.x = cvtpk(v0[0], v0[1]); w.y = cvtpk(v0[2], v0[3]); w.z = cvtpk(v1[0], v1[1]); w.w = cvtpk(v1[2], v1[3]);
                    *(u32x4*)(rowp + bj * HALF) = w; }
                asm volatile("" ::: "memory"); }
    }
};
struct EpiOut {
    static constexpr bool PERM = true, AFTER_DRAIN = false;
    bf16_t* xb; float* ssq;
    __device__ __forceinline__ void operator()(const f32x4 (&acc)[2][2][4][2], const Unit& u, int wr, int wc, int fr, int fq) const {
        const int col0 = u.pn * BM + wc * 32 + 8 * fq;
#pragma unroll
        for (int ai = 0; ai < 2; ++ai)
#pragma unroll
            for (int m = 0; m < 4; ++m) {
                const int row = u.pm * BM + ai * HALF + wr * 64 + m * 16 + fr; const size_t off = (size_t)row * 1024 + col0;
                float q = 0.f;
#pragma unroll
                for (int bj = 0; bj < 2; ++bj) { u32x4* p = (u32x4*)(xb + off + bj * HALF); const u32x4 b = *p;
                    f32x4 o0, o1; o0[0] = __uint_as_float(b.x << 16); o0[1] = __uint_as_float(b.x & 0xffff0000u); o0[2] = __uint_as_float(b.y << 16); o0[3] = __uint_as_float(b.y & 0xffff0000u);
                    o1[0] = __uint_as_float(b.z << 16); o1[1] = __uint_as_float(b.z & 0xffff0000u); o1[2] = __uint_as_float(b.w << 16); o1[3] = __uint_as_float(b.w & 0xffff0000u);
                    o0 = o0 + acc[ai][bj][m][0]; o1 = o1 + acc[ai][bj][m][1];
                    q += ((o0[0] * o0[0] + o0[1] * o0[1]) + (o0[2] * o0[2] + o0[3] * o0[3])) + ((o1[0] * o1[0] + o1[1] * o1[1]) + (o1[2] * o1[2] + o1[3] * o1[3]));
                    u32x4 w; w.x = cvtpk(o0[0], o0[1]); w.y = cvtpk(o0[2], o0[3]); w.z = cvtpk(o1[0], o1[1]); w.w = cvtpk(o1[2], o1[3]); *p = w; }
                q = sum_rows4(q);
                if (fq == 0) ssq[(size_t)row * 16 + u.pn * 4 + wc] = q;
                if (m == 3) asm volatile("" ::: "memory");
            }
    }
};
template <class Epi, class Sched, bool ALIGN_EPI = false, bool SP2 = false>
__device__ __forceinline__ void gemm_phase(PG8_LAS unsigned char* lds, const Gemm g, const Sched& S, const Epi& E) {
    int tid = threadIdx.x; asm volatile("" : "+v"(tid));
    const int wid = __builtin_amdgcn_readfirstlane(tid >> 6), lane = tid & 63, wr = wid >> 2, wc = wid & 3, fr = lane & 15, fq = lane >> 4;
    const int K = g.K, nt = K / BK;
    unsigned voffA[2], voffB[2];
#pragma unroll
    for (int i = 0; i < 2; ++i) { int R, C; stage_rc(tid * 16 + i * 8192, R, C); const int Rb = Epi::PERM ? ((R & ~31) + perm32(R & 31)) : R;
        voffA[i] = (unsigned)(R * K + C) * 2u; voffB[i] = (unsigned)(Rb * K + C) * 2u; }
    const size_t kstep = (size_t)(BK * 2);
    const size_t hstep = (size_t)HALF * K * 2;
    const size_t tstep = 2 * hstep;
    const unsigned ldsw = (unsigned)wid * 1024u;
    const int aoff = lds_byte(wr * 64 + fr, fq * 8), boff = lds_byte(wc * 32 + fr, fq * 8);
#define PG8_SA(b, h) (((b) * 2 + (h)) * HTB)
#define PG8_SB(b, h) ((4 + (b) * 2 + (h)) * HTB)
#define PG8_STAGE(bufoff, gbase, voff) do { _Pragma("unroll") for (int _i = 0; _i < 2; ++_i) \
        __builtin_amdgcn_global_load_lds((const unsigned*)((const char*)(gbase) + (voff)[_i]), (PG8_LAS unsigned*)(lds + (bufoff) + ldsw + _i * 8192), 16, 0, 0); } while (0)
#define PG8_LDA(dst, b, h) do { _Pragma("unroll") for (int m = 0; m < 4; ++m) _Pragma("unroll") for (int k = 0; k < 2; ++k) dst[m][k] = *(const PG8_LAS bf16x8*)(lds + PG8_SA(b, h) + aoff + m * 2048 + k * 1024); } while (0)
#define PG8_LDB(dst, b, h) do { _Pragma("unroll") for (int n = 0; n < 2; ++n) _Pragma("unroll") for (int k = 0; k < 2; ++k) dst[n][k] = *(const PG8_LAS bf16x8*)(lds + PG8_SB(b, h) + boff + n * 2048 + k * 1024); } while (0)
#define PG8_MMA(ai, bj, At, Bt) do { __builtin_amdgcn_s_setprio(1); _Pragma("unroll") for (int m = 0; m < 4; ++m) _Pragma("unroll") for (int n = 0; n < 2; ++n) _Pragma("unroll") for (int k = 0; k < 2; ++k) \
        acc[ai][bj][m][n] = __builtin_amdgcn_mfma_f32_16x16x32_bf16(Bt[n][k], At[m][k], acc[ai][bj][m][n], 0, 0, 0); __builtin_amdgcn_s_setprio(0); } while (0)
#define PG8_WAIT_V(n) asm volatile("s_waitcnt vmcnt(" #n ")" ::: "memory")
#define PG8_WAIT_L(n) asm volatile("s_waitcnt lgkmcnt(" #n ")" ::: "memory")
#define PG8_BAR __builtin_amdgcn_s_barrier()
#define PG8_SCHED __builtin_amdgcn_sched_barrier(0)
    Unit cur, nxt; int ui = 0;
    if (!S.next(0, cur)) return;
    f32x4 acc[2][2][4][2];
#pragma unroll
    for (int a = 0; a < 2; ++a)
#pragma unroll
        for (int b = 0; b < 2; ++b)
#pragma unroll
            for (int m = 0; m < 4; ++m)
#pragma unroll
                for (int n = 0; n < 2; ++n) acc[a][b][m][n] = (f32x4){0.f, 0.f, 0.f, 0.f};
    bf16x8 At[4][2], B0[2][2], B1[2][2];
    const char* cA = (const char*)g.A + (size_t)cur.pm * tstep; const char* cB = (const char*)g.Bt + (size_t)cur.pn * tstep;
    S.a_ready(cur);
    if constexpr (SP2) {
        PG8_STAGE(PG8_SB(0, 0), cB, voffB); PG8_STAGE(PG8_SB(0, 1), cB + hstep, voffB); PG8_STAGE(PG8_SA(0, 0), cA, voffA); PG8_STAGE(PG8_SA(0, 1), cA + hstep, voffA);
        if (wr == 1) PG8_BAR;
        PG8_WAIT_V(2); PG8_BAR;
        PG8_STAGE(PG8_SB(1, 0), cB + kstep, voffB); PG8_STAGE(PG8_SA(1, 0), cA + kstep, voffA); PG8_STAGE(PG8_SB(1, 1), cB + hstep + kstep, voffB);
        PG8_WAIT_V(6); PG8_BAR;
    } else {
        PG8_STAGE(PG8_SB(0, 0), cB, voffB); PG8_STAGE(PG8_SA(0, 0), cA, voffA); PG8_STAGE(PG8_SB(0, 1), cB + hstep, voffB); PG8_STAGE(PG8_SA(0, 1), cA + hstep, voffA);
        if (wr == 1) PG8_BAR;
        PG8_WAIT_V(4); PG8_BAR;
        PG8_STAGE(PG8_SB(1, 0), cB + kstep, voffB); PG8_STAGE(PG8_SA(1, 0), cA + kstep, voffA); PG8_STAGE(PG8_SB(1, 1), cB + hstep + kstep, voffB);
        PG8_WAIT_V(6); PG8_BAR;
    }
    for (;;) {
        const bool has_next = S.next(ui + 1, nxt);
        const char* nA = has_next ? (const char*)g.A + (size_t)nxt.pm * tstep : cA; const char* nB = has_next ? (const char*)g.Bt + (size_t)nxt.pn * tstep : cB;
        for (int t = 0; t < nt; t += 2) {
            const bool last = (t == nt - 2);
            const char* a1 = cA + (size_t)(t + 1) * kstep;
            const char* a2 = last ? nA : cA + (size_t)(t + 2) * kstep; const char* b2 = last ? nB : cB + (size_t)(t + 2) * kstep;
            const char* a3 = a2 + kstep; const char* b3 = b2 + kstep;
            if (last && has_next) S.a_ready(nxt);
            if constexpr (SP2) {
            PG8_LDB(B0, 0, 0); PG8_LDB(B1, 0, 1); PG8_SCHED; PG8_LDA(At, 0, 0); PG8_STAGE(PG8_SA(1, 1), a1 + hstep, voffA);
            PG8_WAIT_V(8); PG8_WAIT_L(0); PG8_BAR; PG8_MMA(0, 0, At, B0); PG8_MMA(0, 1, At, B1); PG8_BAR; PG8_SCHED;
            PG8_LDA(At, 0, 1); PG8_STAGE(PG8_SB(0, 0), b2, voffB); PG8_STAGE(PG8_SB(0, 1), b2 + hstep, voffB); PG8_STAGE(PG8_SA(0, 0), a2, voffA);
            PG8_WAIT_V(8); PG8_WAIT_L(0); PG8_BAR; PG8_MMA(1, 0, At, B0); PG8_MMA(1, 1, At, B1); PG8_BAR; PG8_SCHED;
            PG8_LDB(B0, 1, 0); PG8_LDB(B1, 1, 1); PG8_SCHED; PG8_LDA(At, 1, 0); PG8_STAGE(PG8_SA(0, 1), a2 + hstep, voffA);
            PG8_WAIT_V(8); PG8_WAIT_L(0); PG8_BAR; PG8_MMA(0, 0, At, B0); PG8_MMA(0, 1, At, B1); PG8_BAR; PG8_SCHED;
            PG8_LDA(At, 1, 1); PG8_STAGE(PG8_SB(1, 0), b3, voffB); PG8_STAGE(PG8_SB(1, 1), b3 + hstep, voffB); PG8_STAGE(PG8_SA(1, 0), a3, voffA);
            PG8_WAIT_V(8); PG8_WAIT_L(0); PG8_BAR; PG8_MMA(1, 0, At, B0); PG8_MMA(1, 1, At, B1); PG8_BAR; PG8_SCHED;
            } else {
            PG8_LDB(B0, 0, 0); PG8_SCHED; PG8_LDA(At, 0, 0); PG8_STAGE(PG8_SA(1, 1), a1 + hstep, voffA);
            PG8_WAIT_L(8); PG8_BAR; PG8_WAIT_L(0); PG8_MMA(0, 0, At, B0); PG8_BAR; PG8_SCHED;
            PG8_LDB(B1, 0, 1); PG8_STAGE(PG8_SB(0, 0), b2, voffB);
            PG8_BAR; PG8_WAIT_L(0); PG8_MMA(0, 1, At, B1); PG8_BAR;
            PG8_LDA(At, 0, 1); PG8_STAGE(PG8_SA(0, 0), a2, voffA);
            PG8_BAR; PG8_WAIT_L(0); PG8_MMA(1, 0, At, B0); PG8_BAR; PG8_SCHED;
            PG8_STAGE(PG8_SB(0, 1), b2 + hstep, voffB);
            PG8_WAIT_V(6); PG8_BAR; PG8_MMA(1, 1, At, B1); PG8_BAR;
            PG8_LDB(B0, 1, 0); PG8_SCHED; PG8_LDA(At, 1, 0); PG8_STAGE(PG8_SA(0, 1), a2 + hstep, voffA);
            PG8_WAIT_L(8); PG8_BAR; PG8_WAIT_L(0); PG8_MMA(0, 0, At, B0); PG8_BAR; PG8_SCHED;
            PG8_LDB(B1, 1, 1); PG8_STAGE(PG8_SB(1, 0), b3, voffB);
            PG8_BAR; PG8_WAIT_L(0); PG8_MMA(0, 1, At, B1); PG8_BAR;
            PG8_LDA(At, 1, 1); PG8_STAGE(PG8_SA(1, 0), a3, voffA);
            PG8_BAR; PG8_WAIT_L(0); PG8_MMA(1, 0, At, B0); PG8_BAR; PG8_SCHED;
            PG8_STAGE(PG8_SB(1, 1), b3 + hstep, voffB);
            PG8_WAIT_V(6); PG8_BAR; PG8_MMA(1, 1, At, B1); PG8_BAR;
            }
        }
        if constexpr (ALIGN_EPI) { if (wr == 0) PG8_BAR; }
        if constexpr (!Epi::AFTER_DRAIN) { E(acc, cur, wr, wc, fr, fq); S.done(cur); }
        if (!has_next) break;
#pragma unroll
        for (int a = 0; a < 2; ++a)
#pragma unroll
            for (int b = 0; b < 2; ++b)
#pragma unroll
                for (int m = 0; m < 4; ++m)
#pragma unroll
                    for (int n = 0; n < 2; ++n) acc[a][b][m][n] = (f32x4){0.f, 0.f, 0.f, 0.f};
        cur = nxt; cA = nA; cB = nB; ++ui;
        if constexpr (ALIGN_EPI) { if (wr == 1) PG8_BAR; }
    }
    PG8_WAIT_V(0);
    if constexpr (!ALIGN_EPI) { if (wr == 0) PG8_BAR; }
    PG8_BAR;
    if constexpr (Epi::AFTER_DRAIN) { E.fused(acc, cur, wr, wc, fr, fq, lds, wid, lane); S.done(cur); }
#undef PG8_SA
#undef PG8_SB
#undef PG8_STAGE
#undef PG8_LDA
#undef PG8_LDB
#undef PG8_MMA
#undef PG8_WAIT_V
#undef PG8_WAIT_L
#undef PG8_BAR
#undef PG8_SCHED
}
}
namespace att {
#define LAS __attribute__((address_space(3)))
typedef unsigned short bf16_t;
typedef short bf16x8 __attribute__((ext_vector_type(8)));
typedef float f32x4 __attribute__((ext_vector_type(4)));
typedef float f32x16 __attribute__((ext_vector_type(16)));
typedef unsigned u32x4 __attribute__((ext_vector_type(4)));
typedef unsigned u32x2 __attribute__((ext_vector_type(2)));
typedef float f32x2 __attribute__((ext_vector_type(2)));
using pg8::cvtpk;
constexpr float LOG2E = 1.4426950408889634f;
constexpr float QK_C = 0.125f * LOG2E;
constexpr float MASKED = -3.0e38f, M_INIT = -1.0e30f;
constexpr int DA_KROW = 272, DA_VROW = 128, DA_V_OFF = 64 * DA_KROW, DA_BUF = DA_V_OFF + 128 * DA_VROW, DA_TBL_OFF = 3 * DA_BUF;
constexpr int DA_DL_OFF = DA_TBL_OFF + 3072, DA_DR_OFF = DA_DL_OFF + 2816;
constexpr int NA_SLOT = 64 * 128, NA_TBL_OFF = 11 * NA_SLOT;
static_assert(DA_DR_OFF + 641 * 4 <= 131072 && DA_V_OFF % 128 == 0 && DA_BUF % 128 == 0 && DA_TBL_OFF + 257 * 4 <= 131072 && NA_TBL_OFF + 512 * 4 <= 131072, "attention LDS");

__device__ __forceinline__ int crow(int r, int hi) { return (r & 3) + 8 * (r >> 2) + 4 * hi; }
__device__ __forceinline__ float ex2(float x) { return __builtin_amdgcn_exp2f(x); }
__device__ __forceinline__ float silu(float g) { return g * __builtin_amdgcn_rcpf(1.0f + __builtin_amdgcn_exp2f(g * -1.4426950408889634f)); }
__device__ __forceinline__ f32x16 mfma32(bf16x8 a, bf16x8 b, f32x16 c) { return __builtin_amdgcn_mfma_f32_32x32x16_bf16(a, b, c, 0, 0, 0); }
__device__ __forceinline__ int clampi(int v, int lo, int hi) { return v < lo ? lo : (v > hi ? hi : v); }

__device__ __forceinline__ float xh_max(float v) { auto rr = __builtin_amdgcn_permlane32_swap(__float_as_uint(v), __float_as_uint(v), false, false); return fmaxf(__uint_as_float(rr[0]), __uint_as_float(rr[1])); }
__device__ __forceinline__ float xh_sum(float v) { auto rr = __builtin_amdgcn_permlane32_swap(__float_as_uint(v), __float_as_uint(v), false, false); return __uint_as_float(rr[0]) + __uint_as_float(rr[1]); }
__device__ __forceinline__ float rowmax16(const f32x16& z) {
    float a = fmaxf(fmaxf(z[0], z[1]), z[2]), b = fmaxf(fmaxf(z[3], z[4]), z[5]);
    a = fmaxf(fmaxf(a, z[6]), z[7]); b = fmaxf(fmaxf(b, z[8]), z[9]); a = fmaxf(fmaxf(a, z[10]), z[11]); b = fmaxf(fmaxf(b, z[12]), z[13]); a = fmaxf(fmaxf(a, z[14]), z[15]);
    return fmaxf(a, b);
}
template <int NT> __device__ __forceinline__ void softmax_step(f32x16& z, float& m, float& l, f32x16 (&o)[NT], u32x4& p0, u32x4& p1) {
    float e[16], su = 0.f;
#pragma unroll
    for (int r = 0; r < 16; ++r) { e[r] = ex2(z[r] - m); su += e[r]; }
    if (__builtin_amdgcn_ballot_w64(!(su < 1048576.0f)) != 0ull) {
        float zm = fmaxf(fmaxf(z[0], z[1]), fmaxf(z[2], z[3]));
#pragma unroll
        for (int r = 4; r < 16; r += 4) zm = fmaxf(zm, fmaxf(fmaxf(z[r], z[r + 1]), fmaxf(z[r + 2], z[r + 3])));
        zm = xh_max(zm);
        const bool need = zm > m + 8.0f;
        const float mn = need ? zm : m;
        const float f = ex2(m - mn);
        l *= f;
#pragma unroll
        for (int t = 0; t < NT; ++t)
#pragma unroll
            for (int r = 0; r < 16; ++r) o[t][r] *= f;
        m = mn;
        su = 0.f;
#pragma unroll
        for (int r = 0; r < 16; ++r) { e[r] = ex2(z[r] - m); su += e[r]; }
    }
    l += su;
    p0.x = cvtpk(e[0], e[1]); p0.y = cvtpk(e[2], e[3]); p0.z = cvtpk(e[4], e[5]); p0.w = cvtpk(e[6], e[7]);
    p1.x = cvtpk(e[8], e[9]); p1.y = cvtpk(e[10], e[11]); p1.z = cvtpk(e[12], e[13]); p1.w = cvtpk(e[14], e[15]);
}
__device__ __forceinline__ void tr_store(LAS unsigned char* p, const u32x4 a, const u32x4 b) {
#pragma unroll
    for (int i = 0; i < 4; ++i) {
        *(LAS unsigned*)(p + (2 * i) * 144) = (a[i] & 0xffffu) | (b[i] << 16);
        *(LAS unsigned*)(p + (2 * i + 1) * 144) = (a[i] >> 16) | (b[i] & 0xffff0000u);
    }
}
__device__ __forceinline__ int vpos_of(int c) { const int c16 = c & 15; return (c & ~15) + 8 * ((c16 >> 2) & 1) + (c16 & 3) + 4 * (c16 >> 3); }

__device__ __forceinline__ int vsw(int d) { return ((d >> 3) & 1) | (((d >> 4) & 1) << 1) | ((((d >> 1) ^ (d >> 5)) & 1) << 2); }
__device__ __forceinline__ void da_unit(LAS unsigned char* lds, const bf16_t* __restrict__ proj, bf16_t* __restrict__ y, int unit,
                                        const float* __restrict__ t5, float lam, float one_m_li, const float* __restrict__ subg) {
    int tid = threadIdx.x; asm volatile("" : "+v"(tid));
    const int lane = tid & 63, wid = __builtin_amdgcn_readfirstlane(tid >> 6), l31 = lane & 31, hh = lane >> 5;
    const int qg = wid >> 1, mp = wid & 1;
    const int bh = unit >> 5, qb = unit & 31, b = bh >> 2, h = bh & 3;
    const size_t rowbase = (size_t)b * 4096;
    const int qblk = qb * 128, q0 = qblk + qg * 32, q = q0 + l31;
    LAS float* tbl = (LAS float*)(lds + DA_TBL_OFF);
    __syncthreads();
    if (tid < 257) { const int rel = tid - 128, a = rel < 0 ? -rel : rel; int large = 8 + (31 - __builtin_clz((unsigned)(a * a) | 1u)) - 6; large = large > 15 ? 15 : large;
        const int bucket = (rel > 0 ? 16 : 0) + (a < 8 ? a : large); tbl[tid] = t5[bucket * 4 + h] * LOG2E; }
    LAS float* sgt = (LAS float*)(lds + DA_TBL_OFF + 2048);
    if (tid >= 384) sgt[tid - 384] = subg[tid - 384];
    { const float bl_ = t5[15 * 4 + h], br_ = t5[31 * 4 + h];
#pragma unroll
      for (int k_ = 0; k_ < 3; ++k_) { const int e_ = tid + 512 * k_;
          if (e_ < 2 * 641) { const int side = e_ >= 641 ? 1 : 0, rel0 = e_ - 641 * side - 320, rel = clampi(rel0, -128, 128), a = rel < 0 ? -rel : rel;
              int large = 8 + (31 - __builtin_clz((unsigned)(a * a) | 1u)) - 6; large = large > 15 ? 15 : large;
              const int bucket = (rel > 0 ? 16 : 0) + (a < 8 ? a : large);
              ((LAS float*)(lds + DA_DL_OFF))[e_ + (side ? (DA_DR_OFF - DA_DL_OFF) / 4 - 641 : 0)] = (t5[bucket * 4 + h] - (side ? br_ : bl_)) * (LOG2E / QK_C); } } }
    float tbmax = t5[l31 * 4 + h] * LOG2E;
#pragma unroll
    for (int o_ = 1; o_ < 32; o_ <<= 1) tbmax = fmaxf(tbmax, __shfl_xor(tbmax, o_));
    const bf16_t* qp = proj + (rowbase + q) * 4096 + 2048 + h * 128 + mp * 64 + hh * 8;
    bf16x8 qf[4];
#pragma unroll
    for (int ks = 0; ks < 4; ++ks) qf[ks] = *(const bf16x8*)(qp + ks * 16);
    const int kc = tid & 15, kr = tid >> 4;
    const bf16_t* kvbase = proj + rowbase * 4096 + 2560 + h * 128;
    const unsigned kgo = (unsigned)(kr * 4096 + kc * 8), vgo = (unsigned)(2 * kr * 4096 + 512 + kc * 8);
    const int vps = vpos_of(2 * kr), vch = vps >> 3, vswc = vsw(8 * kc);
    const unsigned kw = kr * DA_KROW + kc * 16, vwb = DA_V_OFF + (8 * kc) * DA_VROW + ((vps & 7) >> 1) * 4;
    const unsigned vwA = vwb + ((vch ^ vswc) << 4), vwB = vwb + ((vch ^ vswc ^ 4) << 4);
    const unsigned vrd = (unsigned)(DA_V_OFF + l31 * DA_VROW) ^ (unsigned)((hh ^ vsw(l31)) << 4);
    u32x4 kreg0, kreg1, vreg0, vreg1;
#define DA_LOAD(j) do { const bf16_t* t_ = kvbase + (size_t)(j) * 64 * 4096; kreg0 = *(const u32x4*)(t_ + kgo); kreg1 = *(const u32x4*)(t_ + (kgo + 32u * 4096u)); vreg0 = *(const u32x4*)(t_ + vgo); vreg1 = *(const u32x4*)(t_ + (vgo + 4096u)); } while (0)
#define DA_STORE(B_) do { *(LAS u32x4*)((B_) + kw) = kreg0; *(LAS u32x4*)((B_) + kw + 32 * DA_KROW) = kreg1; \
        _Pragma("unroll") for (int i_ = 0; i_ < 4; ++i_) { LAS unsigned char* p_ = (B_) + ((i_ & 1) ? vwB : vwA) + (2 * i_) * DA_VROW; \
            *(LAS unsigned*)(p_) = __builtin_amdgcn_perm(vreg1[i_], vreg0[i_], 0x05040100u); *(LAS unsigned*)(p_ + DA_VROW) = __builtin_amdgcn_perm(vreg1[i_], vreg0[i_], 0x07060302u); } } while (0)
#define DA_KLD(KF_, Bk, sub) do { const LAS unsigned char* kp_ = (Bk) + (32 * (sub) + l31) * DA_KROW + mp * 128 + hh * 16; \
        _Pragma("unroll") for (int ks = 0; ks < 4; ++ks) KF_[ks] = *(const LAS bf16x8*)(kp_ + ks * 32); } while (0)
#define DA_VLD(VF_, Bv, sub, s2_) do { const unsigned r_ = (unsigned)(uintptr_t)(Bv) + vrd; \
        _Pragma("unroll") for (int dt = 0; dt < 4; ++dt) VF_[dt] = *(const LAS bf16x8*)(uintptr_t)((r_ ^ (unsigned)((4 * (sub) + 2 * (s2_)) ^ ((dt & 1) << 2)) << 4) + dt * 32 * DA_VROW); } while (0)
#define DA_QKM(S_, KF_) do { { f32x16 z_; _Pragma("unroll") for (int r_ = 0; r_ < 16; ++r_) z_[r_] = 0.f; S_ = mfma32(KF_[0], qf[0], z_); } _Pragma("unroll") for (int ks = 1; ks < 4; ++ks) S_ = mfma32(KF_[ks], qf[ks], S_); } while (0)
#define DA_PVM(VF_, P_) do { _Pragma("unroll") for (int dt = 0; dt < 4; ++dt) o[dt] = mfma32(VF_[dt], __builtin_bit_cast(bf16x8, P_), o[dt]); } while (0)
#define SB0() __builtin_amdgcn_sched_barrier(0)
#define DA_RESC(sm_, bc_) do { const float zm_ = (sm_) * QK_C + (bc_); const bool need_ = zm_ > m + 8.0f; \
        if (__builtin_amdgcn_ballot_w64(need_) != 0ull) { const float mn_ = need_ ? zm_ : m; const float f_ = ex2(m - mn_); l *= f_; \
            _Pragma("unroll") for (int t_ = 0; t_ < 4; ++t_) _Pragma("unroll") for (int r_ = 0; r_ < 16; ++r_) o[t_][r_] *= f_; \
            m = mn_; } } while (0)
#define DA_EXPO(S_, bc_, P0_, P1_, su_) do { const float c_ = (bc_) - m; float e_[16]; \
        _Pragma("unroll") for (int r_ = 0; r_ < 16; ++r_) e_[r_] = ex2(S_[r_] * QK_C + c_); \
        su_ = 0.f; _Pragma("unroll") for (int r_ = 0; r_ < 16; ++r_) su_ += e_[r_]; \
        P0_.x = cvtpk(e_[0], e_[1]); P0_.y = cvtpk(e_[2], e_[3]); P0_.z = cvtpk(e_[4], e_[5]); P0_.w = cvtpk(e_[6], e_[7]); \
        P1_.x = cvtpk(e_[8], e_[9]); P1_.y = cvtpk(e_[10], e_[11]); P1_.z = cvtpk(e_[12], e_[13]); P1_.w = cvtpk(e_[14], e_[15]); } while (0)
    f32x16 o[4];
#pragma unroll
    for (int t = 0; t < 4; ++t)
#pragma unroll
        for (int r = 0; r < 16; ++r) o[t][r] = 0.f;
    float m = M_INIT, l = 0.f;
    {
      const u32x4 a0 = *(const u32x4*)(kvbase + kgo), a1 = *(const u32x4*)(kvbase + (kgo + 32u * 4096u)), a2 = *(const u32x4*)(kvbase + vgo), a3 = *(const u32x4*)(kvbase + (vgo + 4096u));
      DA_LOAD(1);
      const u32x4 b0 = kreg0, b1 = kreg1, b2 = vreg0, b3 = vreg1;
      DA_LOAD(2);
      const u32x4 c0 = kreg0, c1 = kreg1, c2 = vreg0, c3 = vreg1;
      kreg0 = a0; kreg1 = a1; vreg0 = a2; vreg1 = a3; DA_STORE(lds);
      kreg0 = b0; kreg1 = b1; vreg0 = b2; vreg1 = b3; DA_STORE(lds + DA_BUF);
      kreg0 = c0; kreg1 = c1; vreg0 = c2; vreg1 = c3; }
    __syncthreads();
    f32x16 sa, sb;
    bf16x8 kF[4], vF[4], vS[4];
    u32x4 pp0 = {0u, 0u, 0u, 0u}, pp1 = {0u, 0u, 0u, 0u}, pc0, pc1;
    int bcur = 0, bprev = 0, bnext = DA_BUF, bnn = 2 * DA_BUF;
    bool near = (63 >= qblk - 128) && (0 <= qblk + 255); float bc = tbl[0];
    int dtoff = DA_DL_OFF;
    DA_KLD(kF, lds, 0); DA_QKM(sa, kF);
    DA_VLD(vF, lds + bprev, 1, 0);
#define DA_STEP(SC_, SN_, PP0_, PP1_, PC0_, PC1_, Bpv_, subpv_, Bqk_, subqk_, kvbc_, Bv_, subv_) do { \
        if (!((kvbc_) - (q0 + 31) >= 128 || q0 - ((kvbc_) + 31) >= 128)) {     \
            const LAS float* dp_ = (const LAS float*)(lds + dtoff) + ((kvbc_) - q + 320 + 4 * hh); \
            _Pragma("unroll") for (int r_ = 0; r_ < 16; ++r_) SC_[r_] += dp_[(r_ & 3) + 8 * (r_ >> 2)]; }     \
        DA_VLD(vS, Bpv_, subpv_, 1); SB0(); \
        DA_PVM(vF, PP0_); SB0(); \
        DA_KLD(kF, Bqk_, subqk_); SB0(); \
        DA_PVM(vS, PP1_); \
        DA_VLD(vF, Bv_, subv_, 0); SB0(); \
        DA_QKM(SN_, kF); \
        float su_; \
        DA_EXPO(SC_, bc, PC0_, PC1_, su_); \
        if (__builtin_amdgcn_ballot_w64(!(su_ < 1048576.0f)) != 0ull) {     \
            const float sm_ = xh_max(rowmax16(SC_)); \
            DA_RESC(sm_, bc); \
            DA_EXPO(SC_, bc, PC0_, PC1_, su_); } \
        l += su_; } while (0)
#pragma unroll 2
    for (int j = 0; j < 64; ++j) {
        const int j1 = j + 1;
        const bool near1 = (64 * j1 + 63 >= qblk - 128) && (64 * j1 <= qblk + 255);
        const float bc1 = tbl[(64 * j1 > qblk) ? 256 : 0]; const int dtoff1 = (64 * j1 > qblk) ? DA_DR_OFF : DA_DL_OFF;
        DA_STEP(sa, sb, pp0, pp1, pc0, pc1, lds + bprev, 1, lds + bcur, 1, j * 64, lds + bcur, 0);
        __syncthreads();
        DA_STORE(lds + bnn); { const int jl = j + 3 < 64 ? j + 3 : 63; DA_LOAD(jl); }
        DA_STEP(sb, sa, pc0, pc1, pp0, pp1, lds + bcur, 0, lds + bnext, 0, j * 64 + 32, lds + bcur, 1);
        bprev = bcur; bcur = bnext; bnext = bnn; bnn = bprev; near = near1; bc = bc1; dtoff = dtoff1;
    }
    const bf16_t* gp = proj + (rowbase + q) * 4096 + 3584 + h * 128;
    u32x2 gvv[16];
    if (mp == 0) {
#pragma unroll
        for (int i = 0; i < 16; ++i) gvv[i] = *(const u32x2*)(gp + (i >> 2) * 32 + 8 * (i & 3) + 4 * hh);
    }
    DA_VLD(vS, lds + bprev, 1, 1);
    DA_PVM(vF, pp0); DA_PVM(vS, pp1);
    __syncthreads();
#undef DA_EXPO
#undef DA_RESC
#undef DA_STEP
#undef DA_KLD
#undef DA_VLD
#undef DA_QKM
#undef DA_PVM
#undef SB0
#undef DA_LOAD
#undef DA_STORE
    l = xh_sum(l);
    const float sc = (mp == 0 ? 1.0f : lam) * __builtin_amdgcn_rcpf(l);
    LAS float* ex = (LAS float*)lds + (qg * 128) * 32 + l31;
    if (mp == 1) {
#pragma unroll
        for (int dt = 0; dt < 4; ++dt)
#pragma unroll
            for (int r = 0; r < 16; ++r) ex[(dt * 32 + crow(r, hh)) * 32] = o[dt][r] * sc;
    }
    __syncthreads();
    if (mp == 0) {
        float ss = 0.f;
#pragma unroll
        for (int dt = 0; dt < 4; ++dt)
#pragma unroll
            for (int r = 0; r < 16; ++r) { const float v = o[dt][r] * sc - ex[(dt * 32 + crow(r, hh)) * 32]; o[dt][r] = v; ss += v * v; }
        ss = xh_sum(ss);
        const float rn = one_m_li * __builtin_amdgcn_rsqf(ss * (1.0f / 128.0f) + 1e-5f);
        bf16_t* yp = y + (rowbase + q) * 1024 + 512 + h * 128;
#pragma unroll
        for (int dt = 0; dt < 4; ++dt)
#pragma unroll
            for (int g = 0; g < 4; ++g) {
                const int d = dt * 32 + 8 * g + 4 * hh;
                const u32x2 gv = gvv[dt * 4 + g]; const f32x4 sg = *(const LAS f32x4*)(sgt + d);
                const float g0 = __uint_as_float(gv.x << 16), g1 = __uint_as_float(gv.x & 0xffff0000u), g2 = __uint_as_float(gv.y << 16), g3 = __uint_as_float(gv.y & 0xffff0000u);
                u32x2 w; w.x = cvtpk(o[dt][4 * g] * rn * sg[0] * silu(g0), o[dt][4 * g + 1] * rn * sg[1] * silu(g1));
                w.y = cvtpk(o[dt][4 * g + 2] * rn * sg[2] * silu(g2), o[dt][4 * g + 3] * rn * sg[3] * silu(g3));
                *(u32x2*)(yp + d) = w;
            }
    }
}

__device__ __forceinline__ void na_unit(LAS unsigned char* lds, const bf16_t* __restrict__ proj, bf16_t* __restrict__ y, int unit, const float* __restrict__ rpb) {
    int tid = threadIdx.x; asm volatile("" : "+v"(tid));
    const int lane = tid & 63, wid = __builtin_amdgcn_readfirstlane(tid >> 6), l31 = lane & 31, hh = lane >> 5;
    const int rg = unit & 15, bh = unit >> 4, h = bh & 7, b = bh >> 3;
    const size_t rowbase = (size_t)b * 4096;
    const int r0 = rg * 4, rlo = clampi(r0 - 4, 0, 56), rhi = clampi(r0 - 1, 0, 56) + 7, nrows = rhi - rlo + 1;
    LAS float* tbl = (LAS float*)(lds + NA_TBL_OFF);
    __syncthreads();
    { const int dr = tid >> 5, ci = tid & 31; tbl[tid] = (dr < 15 && ci < 31) ? rpb[h * 465 + dr * 31 + ci] * LOG2E : MASKED; }
    { const int c8 = tid & 7, cp = (tid >> 3) & 31, par = tid >> 8;
      const int pos = vpos_of(2 * cp), ch = pos >> 3, sw0 = vsw(8 * c8);
      const unsigned wb = (8 * c8) * 128 + ((pos & 7) >> 1) * 4, wA = wb + ((ch ^ sw0) << 4), wB = wb + ((ch ^ sw0 ^ 4) << 4);
      const bf16_t* gbase = proj + (rowbase + rlo * 64 + 2 * cp) * 4096 + 1024 + h * 64 + c8 * 8;
      u32x4 va[6], vb[6];
#pragma unroll
      for (int k = 0; k < 6; ++k) { const int i = 2 * k + par, ic = i < nrows ? i : nrows - 1; const bf16_t* g = gbase + (size_t)ic * 64 * 4096; va[k] = *(const u32x4*)g; vb[k] = *(const u32x4*)(g + 4096); }
#pragma unroll
      for (int k = 0; k < 6; ++k) { const int i = 2 * k + par; if (i < nrows) { LAS unsigned char* S = lds + i * NA_SLOT;
#pragma unroll
          for (int i2 = 0; i2 < 4; ++i2) { LAS unsigned char* p = S + ((i2 & 1) ? wB : wA) + (2 * i2) * 128;
              *(LAS unsigned*)p = __builtin_amdgcn_perm(vb[k][i2], va[k][i2], 0x05040100u); *(LAS unsigned*)(p + 128) = __builtin_amdgcn_perm(vb[k][i2], va[k][i2], 0x07060302u); } } }
    }
    __syncthreads();
    const int rf = r0 + 2 * (wid >> 2), kblk = wid & 3, c0 = 16 * kblk;
    const int r = rf + (l31 >> 4), c = c0 + (l31 & 15), rs = clampi(r - 4, 0, 56), cs = clampi(c - 8, 0, 48);
    const int rst = clampi(rf - 4, 0, 56), ntile = clampi(rf - 3, 0, 56) - rst + 8;
    const bf16_t* qp = proj + (rowbase + r * 64 + c) * 4096 + h * 64 + hh * 8;
    bf16x8 qf[4];
#pragma unroll
    for (int ks = 0; ks < 4; ++ks) qf[ks] = *(const bf16x8*)(qp + ks * 16);
    unsigned cpk[4];
#pragma unroll
    for (int w = 0; w < 4; ++w) { unsigned v = 0u;
#pragma unroll
        for (int e4 = 0; e4 < 4; ++e4) { const int kcol = c0 - 8 + crow(4 * w + e4, hh); const bool valid = (kcol >= cs) && (kcol <= cs + 15);
            v |= (unsigned)(valid ? kcol - c + 15 : 31) << (8 * e4); }
        cpk[w] = v; }
    f32x16 o[2];
#pragma unroll
    for (int t = 0; t < 2; ++t)
#pragma unroll
        for (int rr = 0; rr < 16; ++rr) o[t][rr] = 0.f;
    float m = M_INIT, l = 0.f;
    const bf16_t* kbase = proj + (rowbase + rst * 64 + clampi(c0 - 8 + l31, 0, 63)) * 4096 + 512 + h * 64 + hh * 8;
#define NA_KPTR(t_) (kbase + (size_t)(t_) * 64 * 4096)
    const unsigned vrd = (unsigned)(l31 * 128) ^ (unsigned)((hh ^ vsw(l31)) << 4);
    const unsigned xa0 = (unsigned)(2 * clampi(kblk - 1, 0, 3)) << 4, xb0 = (unsigned)(2 * kblk) << 4, xa1 = xb0, xb1 = (unsigned)(2 * clampi(kblk + 1, 0, 3)) << 4;
    bf16x8 kq[4][4];
#pragma unroll
    for (int t = 0; t < 3; ++t)
#pragma unroll
        for (int ks = 0; ks < 4; ++ks) kq[t][ks] = *(const bf16x8*)(NA_KPTR(t) + ks * 16);
#pragma unroll
    for (int t = 0; t < 9; ++t) {
        if (t < 8 || ntile == 9) {
        { const int tl = (t + 3 < ntile) ? t + 3 : ntile - 1;
#pragma unroll
          for (int ks = 0; ks < 4; ++ks) kq[(t + 3) & 3][ks] = *(const bf16x8*)(NA_KPTR(tl) + ks * 16); }
        const int krow = rst + t;
        const LAS float* trow = tbl + (((krow >= rs) && (krow <= rs + 7)) ? krow - r + 7 : 15) * 32;
        const unsigned vslot = (unsigned)(uintptr_t)(lds + (krow - rlo) * NA_SLOT) + vrd;
        f32x16 s;
        { f32x16 z;
#pragma unroll
          for (int rr = 0; rr < 16; ++rr) z[rr] = 0.f;
          s = mfma32(kq[t & 3][0], qf[0], z); }
#pragma unroll
        for (int ks = 1; ks < 4; ++ks) s = mfma32(kq[t & 3][ks], qf[ks], s);
#pragma unroll
        for (int rr = 0; rr < 16; ++rr) { const unsigned ci = (cpk[rr >> 2] >> (8 * (rr & 3))) & 0xffu; s[rr] = s[rr] * QK_C + trow[ci]; }
        u32x4 p0, p1;
        softmax_step<2>(s, m, l, o, p0, p1);
#pragma unroll
        for (int dt = 0; dt < 2; ++dt) {
            const unsigned dx = (unsigned)((dt & 1) << 2) << 4, db = dt * 32 * 128;
            const u32x2 a0 = *(const LAS u32x2*)(uintptr_t)((vslot ^ xa0 ^ dx) + db + 8), b0 = *(const LAS u32x2*)(uintptr_t)((vslot ^ xb0 ^ dx) + db);
            const u32x2 a1 = *(const LAS u32x2*)(uintptr_t)((vslot ^ xa1 ^ dx) + db + 8), b1 = *(const LAS u32x2*)(uintptr_t)((vslot ^ xb1 ^ dx) + db);
            const u32x4 v0 = {a0.x, a0.y, b0.x, b0.y}, v1 = {a1.x, a1.y, b1.x, b1.y};
            o[dt] = mfma32(__builtin_bit_cast(bf16x8, v0), __builtin_bit_cast(bf16x8, p0), o[dt]);
            o[dt] = mfma32(__builtin_bit_cast(bf16x8, v1), __builtin_bit_cast(bf16x8, p1), o[dt]);
        }
        }
    }
#undef NA_KPTR
    l = xh_sum(l);
    const float il = __builtin_amdgcn_rcpf(l);
    const size_t tok = rowbase + r * 64 + c;
    const bf16_t* gp = proj + tok * 4096 + 1536 + h * 64;
    bf16_t* yp = y + tok * 1024 + h * 64;
#pragma unroll
    for (int dt = 0; dt < 2; ++dt)
#pragma unroll
        for (int g = 0; g < 4; ++g) {
            const int d = dt * 32 + 8 * g + 4 * hh;
            const u32x2 gv = *(const u32x2*)(gp + d);
            const float g0 = __uint_as_float(gv.x << 16), g1 = __uint_as_float(gv.x & 0xffff0000u), g2 = __uint_as_float(gv.y << 16), g3 = __uint_as_float(gv.y & 0xffff0000u);
            u32x2 w; w.x = cvtpk(o[dt][4 * g] * il * silu(g0), o[dt][4 * g + 1] * il * silu(g1));
            w.y = cvtpk(o[dt][4 * g + 2] * il * silu(g2), o[dt][4 * g + 3] * il * silu(g3));
            *(u32x2*)(yp + d) = w;
        }
}
}
typedef unsigned short bf16_t;
constexpr int M_TOK = 65536, DMODEL = 1024, NIN = 4096, DEPTH = 4;
constexpr size_t MiB = 1u << 20;
constexpr size_t WS_WIN = 0, WS_WOUT = 32 * MiB, WS_SSQ = 40 * MiB, WS_XB = 64 * MiB, WS_Y = 192 * MiB, WS_PROJ = 320 * MiB, WS_CTL = 832 * MiB, CTL_BYTES = 16384, WS_END = 833 * MiB;
constexpr int LDS_BYTES = 131072 + 256, MISC_OFF = 131072;
#ifndef MK_N_LAUNCHES
#define MK_N_LAUNCHES 1
#endif

__device__ __forceinline__ float wave_sum(float v) {
#pragma unroll
    for (int o = 1; o < 64; o <<= 1) v += __shfl_xor(v, o);
    return v;
}
__device__ __forceinline__ void p0_transpose_item(const float* W, int K, int N, bf16_t* WT, const float* gk, LAS float* scr, int item, int lane) {
    const int nblk = N / 32, kb = item / nblk, nb = item % nblk, k0 = 64 * kb, n0 = 32 * nb;
    float wv[32];
#pragma unroll
    for (int i = 0; i < 32; ++i) { const int kk = 2 * i + (lane >> 5); wv[i] = W[(size_t)(k0 + kk) * N + n0 + (lane & 31)]; }
#pragma unroll
    for (int i = 0; i < 32; ++i) { const int kk = 2 * i + (lane >> 5); const float g = gk ? gk[k0 + kk] : 1.0f; scr[kk * 33 + (lane & 31)] = wv[i] * g; }
    asm volatile("s_waitcnt lgkmcnt(0)" ::: "memory");
    const int c = lane & 7;
#pragma unroll
    for (int j = 0; j < 4; ++j) { const int n = (lane >> 3) + 8 * j; const LAS float* s = scr + (8 * c) * 33 + n;
        att::u32x4 o; o.x = pg8::cvtpk(s[0 * 33], s[1 * 33]); o.y = pg8::cvtpk(s[2 * 33], s[3 * 33]); o.z = pg8::cvtpk(s[4 * 33], s[5 * 33]); o.w = pg8::cvtpk(s[6 * 33], s[7 * 33]);
        *(att::u32x4*)(WT + (size_t)(n0 + n) * K + k0 + 8 * c) = o; }
    asm volatile("s_waitcnt lgkmcnt(0)" ::: "memory");
}

#define XB_TMO      128
#define XB_XCNT(j)  (256  + 64 * (j))
#define XB_XSUB(j)  (1280 + 64 * (j))
#define XB_XGEN(j)  (2304 + 64 * (j))
#define XB_TOP      3328
#define XB_TOPGEN   3392
#define XCD_BAR_WORDS 3456
#define XB_SPIN_CAP (1u << 18)

__device__ __forceinline__ unsigned xb_ld(unsigned* p)              { return __hip_atomic_load(p, __ATOMIC_RELAXED, __HIP_MEMORY_SCOPE_AGENT); }
__device__ __forceinline__ unsigned xb_add(unsigned* p, unsigned v) { return __hip_atomic_fetch_add(p, v, __ATOMIC_RELAXED, __HIP_MEMORY_SCOPE_AGENT); }
__device__ __forceinline__ unsigned xb_xcc_id() { return (unsigned)__builtin_amdgcn_s_getreg((3 << 11) | 20) & 0xFu; }
#define XB_SPIN(cond, bar) do { unsigned _sp = 0; while (cond) { __builtin_amdgcn_s_sleep(1); \
    if ((++_sp & 255u) == 0u) { if (xb_ld(&(bar)[XB_TMO])) break; if (_sp > XB_SPIN_CAP) { atomicAdd(&(bar)[XB_TMO], 1u); break; } } } } while (0)

struct XcdBarrier {
    unsigned* bar; unsigned x;
    volatile LAS unsigned* st;
};

__device__ __forceinline__ XcdBarrier xcd_barrier_post(unsigned* bar, volatile LAS unsigned* st) {
    XcdBarrier b; b.bar = bar; b.x = xb_xcc_id(); b.st = st;
    if (threadIdx.x == 0) (void)xb_add(&bar[XB_XCNT(b.x)], 1u);
    return b;
}
__device__ __forceinline__ void xcd_barrier_complete(unsigned* bar, unsigned x, unsigned& nloc, unsigned& nx) {
    const unsigned G = gridDim.x * gridDim.y * gridDim.z;
    unsigned sum, cnt, mine, sp = 0u;
    for (;;) {
        sum = 0u; cnt = 0u; mine = 0u;
#pragma unroll
        for (unsigned j = 0; j < 16; ++j) { const unsigned c = xb_ld(&bar[XB_XCNT(j)]); sum += c; cnt += (c > 0u) ? 1u : 0u; mine = (j == x) ? c : mine; }
        if (sum == G) break;
        __builtin_amdgcn_s_sleep(1);
        if ((++sp & 255u) == 0u) { if (xb_ld(&bar[XB_TMO])) break; if (sp > XB_SPIN_CAP) { atomicAdd(&bar[XB_TMO], 1u); break; } }
    }
    nloc = mine > 0u ? mine : 1u; nx = cnt > 0u ? cnt : 1u;
}

__device__ __forceinline__ void xcd_barrier(const XcdBarrier& b) {
    asm volatile("s_waitcnt vmcnt(0)" ::: "memory");
    __syncthreads();
    if (threadIdx.x == 0) {
        unsigned* bar = b.bar;
        __builtin_amdgcn_s_waitcnt(0);
        unsigned nloc = b.st[0], nx = b.st[1];
        if (nloc == 0u) { xcd_barrier_complete(bar, b.x, nloc, nx); b.st[0] = nloc; b.st[1] = nx; }
        const unsigned old = xb_add(&bar[XB_XSUB(b.x)], 1u);
        const unsigned gen = old / nloc;
        if (old + 1u == (gen + 1u) * nloc) {
            __builtin_amdgcn_fence(__ATOMIC_RELEASE, "agent");
            asm volatile("s_waitcnt vmcnt(0)" ::: "memory");
            const unsigned og = xb_add(&bar[XB_TOP], 1u);
            const unsigned tg = og / nx;
            if (og + 1u == (tg + 1u) * nx) xb_add(&bar[XB_TOPGEN], 1u);
            else XB_SPIN(xb_ld(&bar[XB_TOPGEN]) == tg, bar);
            __builtin_amdgcn_fence(__ATOMIC_ACQUIRE, "agent");
            xb_add(&bar[XB_XGEN(b.x)], 1u);
            asm volatile("s_waitcnt vmcnt(0)" ::: "memory");
        } else {
            XB_SPIN(xb_ld(&bar[XB_XGEN(b.x)]) == gen, bar);
            __builtin_amdgcn_fence(__ATOMIC_ACQUIRE, "agent");
            asm volatile("s_waitcnt vmcnt(0)" ::: "memory");
        }
    }
    __syncthreads();
}

struct Args { const float* x; const float* norm_g; const float* w_in; const float* rpb; const float* lq1; const float* lk1; const float* lq2; const float* lk2;
              const float* subg; const float* t5; const float* w_out; const float* final_g; float* out; unsigned char* ws; long long ph_lo, ph_hi; };

constexpr int N_PHASES = 14;
__global__ void __launch_bounds__(512, 2) fwd_megakernel(Args a) {
    extern __shared__ __attribute__((aligned(16))) unsigned char lds_raw[];
    LAS unsigned char* lds = (LAS unsigned char*)lds_raw;
    const int G = gridDim.x, bx = blockIdx.x, vcu = (G % 8 == 0) ? (bx % 8) * (G / 8) + bx / 8 : bx;
    const int NGW = G * 8;
    unsigned char* ws = a.ws;
    bf16_t* WinT = (bf16_t*)(ws + WS_WIN); bf16_t* WoutT = (bf16_t*)(ws + WS_WOUT); float* ssq = (float*)(ws + WS_SSQ);
    bf16_t* xb = (bf16_t*)(ws + WS_XB); bf16_t* yb = (bf16_t*)(ws + WS_Y); bf16_t* proj = (bf16_t*)(ws + WS_PROJ);
    const int lo = (int)a.ph_lo, hi = (int)a.ph_hi;
#define IN(k) (lo <= (k) && (k) < hi)
    { int t_ = threadIdx.x; if (t_ < 64) ((volatile LAS unsigned*)(lds + MISC_OFF))[t_] = 0u; __syncthreads(); }
    const XcdBarrier xbar = xcd_barrier_post((unsigned*)(ws + WS_CTL), (volatile LAS unsigned*)(lds + MISC_OFF) + 8);
#define SEAM(k) do { if (IN(k) && IN((k) + 1)) { if ((k) == 0) cg::this_grid().sync(); else xcd_barrier(xbar); } } while (0)

    if (IN(0)) {
        int t0 = threadIdx.x; asm volatile("" : "+v"(t0)); const int lane = t0 & 63, wid = __builtin_amdgcn_readfirstlane(t0 >> 6), gw = bx * 8 + wid;
        LAS float* scr = (LAS float*)(lds + wid * 16384);
        constexpr int I_IN = (DMODEL / 64) * (NIN / 32), I_OUT = (DMODEL / 64) * (DMODEL / 32), I_L = I_IN + I_OUT;
        for (int it = gw; it < DEPTH * I_L; it += NGW) {
            const int l = it / I_L, r = it % I_L;
            if (r < I_IN) p0_transpose_item(a.w_in + (size_t)l * DMODEL * NIN, DMODEL, NIN, WinT + (size_t)l * NIN * DMODEL, a.norm_g + l * DMODEL, scr, r, lane);
            else p0_transpose_item(a.w_out + (size_t)l * DMODEL * DMODEL, DMODEL, DMODEL, WoutT + (size_t)l * DMODEL * DMODEL, nullptr, scr, r - I_IN, lane);
        }
        for (int m = gw; m < M_TOK; m += 2 * NGW) {
            const int mb = (m + NGW < M_TOK) ? m + NGW : m;
            const att::f32x4* xr = (const att::f32x4*)(a.x + (size_t)m * DMODEL) + lane; const att::f32x4* xq = (const att::f32x4*)(a.x + (size_t)mb * DMODEL) + lane;
            att::f32x4 v[4], w4[4]; float s = 0.f, s2 = 0.f;
#pragma unroll
            for (int j = 0; j < 4; ++j) { v[j] = __builtin_nontemporal_load(xr + 64 * j); w4[j] = __builtin_nontemporal_load(xq + 64 * j); }
#pragma unroll
            for (int j = 0; j < 4; ++j) { s += (v[j][0] * v[j][0] + v[j][1] * v[j][1]) + (v[j][2] * v[j][2] + v[j][3] * v[j][3]); s2 += (w4[j][0] * w4[j][0] + w4[j][1] * w4[j][1]) + (w4[j][2] * w4[j][2] + w4[j][3] * w4[j][3]); }
            s = wave_sum(s); s2 = wave_sum(s2);
            att::u32x2* o8 = (att::u32x2*)(xb + (size_t)m * DMODEL) + lane; att::u32x2* o9 = (att::u32x2*)(xb + (size_t)mb * DMODEL) + lane;
#pragma unroll
            for (int j = 0; j < 4; ++j) { att::u32x2 w; w.x = pg8::cvtpk(v[j][0], v[j][1]); w.y = pg8::cvtpk(v[j][2], v[j][3]); o8[64 * j] = w;
                                          att::u32x2 y; y.x = pg8::cvtpk(w4[j][0], w4[j][1]); y.y = pg8::cvtpk(w4[j][2], w4[j][3]); o9[64 * j] = y; }
            if (lane < 16) { ssq[(size_t)m * 16 + lane] = (lane == 0) ? s : 0.f; ssq[(size_t)mb * 16 + lane] = (lane == 0) ? s2 : 0.f; }
        }
    }
    SEAM(0);
    for (int l = 0; l < DEPTH; ++l) {
        if (IN(1 + 3 * l)) {
            pg8::Gemm g{xb, WinT + (size_t)l * NIN * DMODEL, M_TOK, NIN, DMODEL}; pg8::StaticOrder S; S.init(M_TOK, NIN, G, bx);
            pg8::EpiProj E{proj, ssq, NIN};
            pg8::gemm_phase<pg8::EpiProj, pg8::StaticOrder, true, true>(lds, g, S, E);
        }
        SEAM(1 + 3 * l);
        if (IN(2 + 3 * l)) {
            int lz = l, lanez = threadIdx.x; asm volatile("" : "+s"(lz), "+v"(lanez)); lanez &= 63;
            const float li = 0.8f - 0.6f * expf(-0.3f * (float)lz);
            const float p1 = wave_sum(a.lq1[lz * 64 + lanez] * a.lk1[lz * 64 + lanez]), p2 = wave_sum(a.lq2[lz * 64 + lanez] * a.lk2[lz * 64 + lanez]);
            const float lam = __uint_as_float(__builtin_amdgcn_readfirstlane(__float_as_uint(expf(p1) - expf(p2) + li)));
            const int vcuz = vcu + (lz - l);
            for (int u = vcuz; u < 2048; u += G) att::da_unit(lds, proj, yb, u, a.t5, lam, __uint_as_float(__builtin_amdgcn_readfirstlane(__float_as_uint(1.0f - li))), a.subg + lz * 128);
            for (int u = vcuz; u < 2048; u += G) att::na_unit(lds, proj, yb, u, a.rpb + (size_t)lz * 8 * 465);
            __syncthreads();
        }
        SEAM(2 + 3 * l);
        if (IN(3 + 3 * l)) {
            pg8::Gemm g{yb, WoutT + (size_t)l * DMODEL * DMODEL, M_TOK, DMODEL, DMODEL}; pg8::StaticOrder S; S.init(M_TOK, DMODEL, G, bx);
            pg8::EpiOut E{xb, ssq};
            pg8::gemm_phase<pg8::EpiOut, pg8::StaticOrder, true, true>(lds, g, S, E);
        }
        SEAM(3 + 3 * l);
    }
    if (IN(13)) {
        int t13 = threadIdx.x; asm volatile("" : "+v"(t13)); const int lane = t13 & 63, gw = bx * 8 + (t13 >> 6);
        att::f32x4 fg[4];
#pragma unroll
        for (int j = 0; j < 4; ++j) fg[j] = *((const att::f32x4*)a.final_g + lane + 64 * j);
        for (int m = gw; m < M_TOK; m += 2 * NGW) {
            const int mb = (m + NGW < M_TOK) ? m + NGW : m;
            const att::u32x2* xr = (const att::u32x2*)(xb + (size_t)m * DMODEL) + lane; const att::u32x2* xq = (const att::u32x2*)(xb + (size_t)mb * DMODEL) + lane;
            att::u32x2 ra[4], rb[4];
#pragma unroll
            for (int j = 0; j < 4; ++j) { ra[j] = xr[64 * j]; rb[j] = xq[64 * j]; }
            att::f32x4 v[4], w4[4]; float s = 0.f, s2 = 0.f;
#pragma unroll
            for (int j = 0; j < 4; ++j) {
                v[j][0] = __uint_as_float(ra[j].x << 16); v[j][1] = __uint_as_float(ra[j].x & 0xffff0000u); v[j][2] = __uint_as_float(ra[j].y << 16); v[j][3] = __uint_as_float(ra[j].y & 0xffff0000u);
                w4[j][0] = __uint_as_float(rb[j].x << 16); w4[j][1] = __uint_as_float(rb[j].x & 0xffff0000u); w4[j][2] = __uint_as_float(rb[j].y << 16); w4[j][3] = __uint_as_float(rb[j].y & 0xffff0000u);
                s += (v[j][0] * v[j][0] + v[j][1] * v[j][1]) + (v[j][2] * v[j][2] + v[j][3] * v[j][3]); s2 += (w4[j][0] * w4[j][0] + w4[j][1] * w4[j][1]) + (w4[j][2] * w4[j][2] + w4[j][3] * w4[j][3]); }
            s = wave_sum(s); s2 = wave_sum(s2);
            const float rs = 1.0f / sqrtf(s * (1.0f / 1024.0f) + 1e-6f), rs2 = 1.0f / sqrtf(s2 * (1.0f / 1024.0f) + 1e-6f);
            att::f32x4* orow = (att::f32x4*)(a.out + (size_t)m * DMODEL) + lane; att::f32x4* orow2 = (att::f32x4*)(a.out + (size_t)mb * DMODEL) + lane;
#pragma unroll
            for (int j = 0; j < 4; ++j) { __builtin_nontemporal_store(v[j] * rs * fg[j], orow + 64 * j); __builtin_nontemporal_store(w4[j] * rs2 * fg[j], orow2 + 64 * j); }
        }
    }
#undef IN
#undef SEAM
}

extern "C" void kernel_launch(void* const* d_in, const int* in_sizes, int n_in, void* d_out, int out_size, void* d_ws, size_t ws_size, hipStream_t stream) {
    static int grid = 0;
    if (grid == 0) {
        if (n_in != 12 || in_sizes[0] != M_TOK * DMODEL || out_size != M_TOK * DMODEL || ws_size < WS_END) { fprintf(stderr, "kernel_launch: unexpected shapes (n_in %d, ws %zu)\n", n_in, ws_size); grid = -1; return; }
        int dev = 0, cus = 0, per_cu = 0;
        hipGetDevice(&dev); hipDeviceGetAttribute(&cus, hipDeviceAttributeMultiprocessorCount, dev);
        if (hipFuncSetAttribute((const void*)fwd_megakernel, hipFuncAttributeMaxDynamicSharedMemorySize, LDS_BYTES) != hipSuccess) { fprintf(stderr, "kernel_launch: hipFuncSetAttribute failed\n"); grid = -1; return; }
        if (hipOccupancyMaxActiveBlocksPerMultiprocessor(&per_cu, (const void*)fwd_megakernel, 512, LDS_BYTES) != hipSuccess || per_cu < 1) { fprintf(stderr, "kernel_launch: occupancy query says %d\n", per_cu); per_cu = 1; }
        (void)hipGetLastError();
        grid = cus * 1;
    }
    if (grid < 0) return;
    if (hipMemsetAsync((char*)d_ws + WS_CTL, 0, CTL_BYTES, stream) != hipSuccess) { fprintf(stderr, "kernel_launch: hipMemsetAsync failed\n"); return; }
    Args a{};
    a.x = (const float*)d_in[0]; a.norm_g = (const float*)d_in[1]; a.w_in = (const float*)d_in[2]; a.rpb = (const float*)d_in[3];
    a.lq1 = (const float*)d_in[4]; a.lk1 = (const float*)d_in[5]; a.lq2 = (const float*)d_in[6]; a.lk2 = (const float*)d_in[7];
    a.subg = (const float*)d_in[8]; a.t5 = (const float*)d_in[9]; a.w_out = (const float*)d_in[10]; a.final_g = (const float*)d_in[11];
    a.out = (float*)d_out; a.ws = (unsigned char*)d_ws;
#if MK_N_LAUNCHES == 1
    a.ph_lo = 0; a.ph_hi = N_PHASES;
    void* args[] = {&a};
    const hipError_t e = hipLaunchCooperativeKernel((const void*)fwd_megakernel, dim3(grid), dim3(512), args, LDS_BYTES, stream);
    if (e != hipSuccess) fprintf(stderr, "kernel_launch: cooperative launch failed: %s (grid %d)\n", hipGetErrorString(e), grid);
#else
    for (int p = 0; p < N_PHASES; ++p) { a.ph_lo = p; a.ph_hi = p + 1; hipLaunchKernelGGL(fwd_megakernel, dim3(grid), dim3(512), LDS_BYTES, stream, a); }
#endif
}
```
